# Optimizing an MI355X kernel written in HIP

```python
import math
import jax
import jax.numpy as jnp
from jax import lax
import numpy as np


D_MODEL = 1024
BATCH = 8
SEQ = 2048
DEPTH = 2

CTX_LEN = 256
GRID_W = 64
HEAD_DIM = 64
ROPE_AXIS_DIM = HEAD_DIM // 2
ROPE_THETA = 10000.0
Q_BLOCK = 128
WINDOW = 128
A_Q_HEADS = 8
A_KV_HEADS = 2
A_GROUP = A_Q_HEADS // A_KV_HEADS
A_WIDTH = A_Q_HEADS * HEAD_DIM
B_HEADS = 4
B_V_DIM = 2 * HEAD_DIM
B_WIDTH = B_HEADS * B_V_DIM
IN_SIZES = (A_WIDTH, A_KV_HEADS * HEAD_DIM, A_KV_HEADS * HEAD_DIM,
            B_HEADS * 2 * HEAD_DIM, B_HEADS * 2 * HEAD_DIM, B_WIDTH)
RW_HEADS = D_MODEL // HEAD_DIM
DECAY_LORA = 64
ICLR_LORA = 64
GATE_LORA = 160
LNX_EPS = 64e-5
N_EXPERTS = 256
TOP_K = 8
N_GROUPS = 8
TOPK_GROUPS = 4
EXPERT_FF = 256
SHARED_FF = 256
ROUTED_SCALE = 2.5
MOE_BLOCK = 128
LN_EPS = 1e-5
SUBLN_EPS = 1e-5
N_ATT = (DEPTH + 1) // 2
N_RWKV = DEPTH // 2
DEEPNORM_ALPHA = (2 * DEPTH) ** 0.25
DEEPNORM_BETA = (8 * DEPTH) ** -0.25
NEG_INF = -1e30

kernel_name = 'hybrid_swa_diffattn_rwkv7_moe_dit'


def layer_norm(x, g, b):
    xf = x.astype(jnp.float32)
    mu = jnp.mean(xf, -1, keepdims=True)
    var = jnp.mean(jnp.square(xf - mu), -1, keepdims=True)
    return ((xf - mu) * lax.rsqrt(var + LN_EPS)).astype(x.dtype) * g + b


def modulate(x, shift, scale):
    return x * (1.0 + scale) + shift


def axial_rope(n):
    rows = n // GRID_W
    row = jnp.repeat(jnp.arange(rows), GRID_W).astype(jnp.float32)
    col = jnp.tile(jnp.arange(GRID_W), rows).astype(jnp.float32)
    inv = ROPE_THETA ** (-jnp.arange(0, ROPE_AXIS_DIM, 2, dtype=jnp.float32) / ROPE_AXIS_DIM)
    ar = row[:, None] * inv
    ac = col[:, None] * inv
    ang = jnp.concatenate([ar, ar, ac, ac], -1)
    return jnp.cos(ang), jnp.sin(ang)


def rot_half(x):
    x1, x2 = jnp.split(x, 2, axis=-1)
    return jnp.concatenate([-x2, x1], -1)


def apply_axial_rope(x, cos, sin):
    shape = (x.shape[1],) + (1,) * (x.ndim - 3) + (HEAD_DIM,)
    cos = cos.reshape(shape).astype(x.dtype)
    sin = sin.reshape(shape).astype(x.dtype)
    rot = jnp.concatenate([rot_half(x[..., :ROPE_AXIS_DIM]), rot_half(x[..., ROPE_AXIS_DIM:])], -1)
    return x * cos + rot * sin


def window_sink_attention(q, k, v, k_ctx, v_ctx, sink):
    Bn, S = q.shape[0], q.shape[1]
    nb = S // Q_BLOCK
    L = k_ctx.shape[1]
    scale = HEAD_DIM ** -0.5
    qb = q.reshape(Bn, nb, Q_BLOCK, A_KV_HEADS, A_GROUP, HEAD_DIM)

    def band(t):
        tp = jnp.pad(t, ((0, 0), (Q_BLOCK, Q_BLOCK), (0, 0), (0, 0)))
        tp = tp.reshape(Bn, nb + 2, Q_BLOCK, A_KV_HEADS, HEAD_DIM)
        return jnp.concatenate([tp[:, :-2], tp[:, 1:-1], tp[:, 2:]], axis=2)

    kw, vw = band(k), band(v)
    s_win = jnp.einsum('bnqhgd,bnkhd->bnhgqk', qb, kw).astype(jnp.float32) * scale
    s_ctx = jnp.einsum('bnqhgd,bchd->bnhgqc', qb, k_ctx).astype(jnp.float32) * scale
    qi = jnp.arange(nb)[:, None, None] * Q_BLOCK + jnp.arange(Q_BLOCK)[None, :, None]
    kj = (jnp.arange(nb)[:, None, None] - 1) * Q_BLOCK + jnp.arange(3 * Q_BLOCK)[None, None, :]
    valid = (jnp.abs(qi - kj) <= WINDOW) & (kj >= 0) & (kj < S)
    s_win = jnp.where(valid[None, :, None, None], s_win, NEG_INF)
    sink_col = jnp.broadcast_to(sink.astype(jnp.float32)[None, None, :, :, None, None], s_ctx.shape[:-1] + (1,))
    p = jax.nn.softmax(jnp.concatenate([sink_col, s_ctx, s_win], -1), axis=-1).astype(v.dtype)
    o = (jnp.einsum('bnhgqc,bchd->bnqhgd', p[..., 1:1 + L], v_ctx)
         + jnp.einsum('bnhgqk,bnkhd->bnqhgd', p[..., 1 + L:], vw))
    return o.reshape(Bn, S, A_WIDTH)


def ctx_sink_attention(q, k, v, sink):
    Bn, L = q.shape[0], q.shape[1]
    s = jnp.einsum('bqhgd,bkhd->bhgqk', q, k).astype(jnp.float32) * HEAD_DIM ** -0.5
    sink_col = jnp.broadcast_to(sink.astype(jnp.float32)[None, :, :, None, None], s.shape[:-1] + (1,))
    p = jax.nn.softmax(jnp.concatenate([sink_col, s], -1), axis=-1)[..., 1:].astype(v.dtype)
    return jnp.einsum('bhgqk,bkhd->bqhgd', p, v).reshape(Bn, L, A_WIDTH)


def diff_lambda(lam_vecs, lam_init):
    lv = lam_vecs.astype(jnp.float32)
    return jnp.exp(jnp.sum(lv[0] * lv[1])) - jnp.exp(jnp.sum(lv[2] * lv[3])) + lam_init


def diff_attend(q, k, v, lam):
    s = jnp.einsum('bqhmd,bkhmd->bhmqk', q, k).astype(jnp.float32) * HEAD_DIM ** -0.5
    p = jax.nn.softmax(s, axis=-1)
    a = (p[:, :, 0] - lam * p[:, :, 1]).astype(v.dtype)
    return jnp.einsum('bhqk,bkhe->bqhe', a, v)


def diff_attention_blocks(q, k, v, lam):
    Bn, S = q.shape[0], q.shape[1]
    nb = S // Q_BLOCK
    qb = jnp.moveaxis(q.reshape(Bn, nb, Q_BLOCK, B_HEADS, 2, HEAD_DIM), 1, 0)
    o = lax.map(lambda qq: diff_attend(qq, k, v, lam), qb)
    return jnp.moveaxis(o, 0, 1).reshape(Bn, S, B_HEADS, B_V_DIM)


def diff_head_norm(o, g, lam_init):
    of = o.astype(jnp.float32)
    of = of * lax.rsqrt(jnp.mean(of * of, -1, keepdims=True) + SUBLN_EPS)
    return of.astype(o.dtype) * g * (1.0 - lam_init)


def split_cols(h, sizes):
    offs = np.cumsum(sizes)[:-1]
    return jnp.split(h, [int(o) for o in offs], axis=-1)


def attn_mixer(u_ctx, u_lat, w_in, w_out, sink, lam_vecs, subln_g, lam_init, cos, sin, emit_ctx):
    Bn, L = u_ctx.shape[0], u_ctx.shape[1]
    S = u_lat.shape[1]
    N = L + S
    h = jnp.concatenate([u_ctx, u_lat], 1) @ w_in
    qa, ka, va, qb, kb, vb = split_cols(h, IN_SIZES)
    qa = qa.reshape(Bn, N, A_KV_HEADS, A_GROUP, HEAD_DIM)
    ka = ka.reshape(Bn, N, A_KV_HEADS, HEAD_DIM)
    va = va.reshape(Bn, N, A_KV_HEADS, HEAD_DIM)
    qb = qb.reshape(Bn, N, B_HEADS, 2, HEAD_DIM)
    kb = kb.reshape(Bn, N, B_HEADS, 2, HEAD_DIM)
    vb = vb.reshape(Bn, N, B_HEADS, B_V_DIM)
    qa_l = apply_axial_rope(qa[:, L:], cos, sin)
    ka_l = apply_axial_rope(ka[:, L:], cos, sin)
    qb_l = apply_axial_rope(qb[:, L:], cos, sin)
    kb_l = apply_axial_rope(kb[:, L:], cos, sin)
    ka_c, va_c, kb_c = ka[:, :L], va[:, :L], kb[:, :L]
    lam = diff_lambda(lam_vecs, lam_init)
    oa_l = window_sink_attention(qa_l, ka_l, va[:, L:], ka_c, va_c, sink)
    kb_all = jnp.concatenate([kb_c, kb_l], 1)
    ob_l = diff_head_norm(diff_attention_blocks(qb_l, kb_all, vb, lam), subln_g, lam_init)
    o_lat = jnp.concatenate([oa_l, ob_l.reshape(Bn, S, B_WIDTH)], -1) @ w_out
    if not emit_ctx:
        return None, o_lat
    oa_c = ctx_sink_attention(qa[:, :L], ka_c, va_c, sink)
    ob_c = diff_head_norm(diff_attend(qb[:, :L], kb_c, vb[:, :L], lam), subln_g, lam_init)
    o_ctx = jnp.concatenate([oa_c, ob_c.reshape(Bn, L, B_WIDTH)], -1) @ w_out
    return o_ctx, o_lat


def centred_shift_delta(x):
    xp = jnp.pad(x, ((0, 0), (1, 1), (0, 0)))
    return 0.5 * (xp[:, :-2] + xp[:, 2:]) - x


def wkv_scan(state0, seq, reverse, emit):
    def step(st, inp):
        r, w, k, v, a, b = inp
        sa = jnp.einsum('bhvk,bhk->bhv', st, a)
        st = st * w[:, :, None, :] + sa[..., None] * b[:, :, None, :] + v[..., None] * k[:, :, None, :]
        y = jnp.einsum('bhvk,bhk->bhv', st, r) if emit else None
        return st, y
    return lax.scan(step, state0, seq, reverse=reverse)


def rwkv7_bidir_mixer(u_ctx, u_lat, mu, w_rkv, w_out, dec0, dec1, dec2, icl0, icl1, icl2,
                      gate1, gate2, k_k, k_a, r_k, lnx, emit_ctx):
    Bn, L, D = u_ctx.shape
    u = jnp.concatenate([u_ctx, u_lat], 1)
    Nt = u.shape[1]
    dx = jnp.concatenate([centred_shift_delta(u_ctx), centred_shift_delta(u_lat)], 1)
    xr, xw, xk, xv, xa, xg = [u + dx * mu[m] for m in range(6)]
    r, k, v = xr @ w_rkv[0], xk @ w_rkv[1], xv @ w_rkv[2]
    g = jax.nn.sigmoid(xg @ gate1) @ gate2

    def heads(t):
        return t.astype(jnp.float32).reshape(Bn, Nt, RW_HEADS, HEAD_DIM)

    r_h, k_h, v_h = heads(r), heads(k), heads(v)
    kk = heads(k * k_k)
    kk = kk * lax.rsqrt(jnp.maximum(jnp.sum(kk * kk, -1, keepdims=True), 1e-24))
    k_a_h = k_a.astype(jnp.float32).reshape(RW_HEADS, HEAD_DIM)
    state0 = jnp.zeros((Bn, RW_HEADS, HEAD_DIM, HEAD_DIM), jnp.float32)
    y_lat_dirs, y_ctx_dirs, k_dirs = [], [], []
    for d in range(2):
        logw = -jax.nn.softplus(-(dec0[d] + jnp.tanh(xw @ dec1[d]) @ dec2[d])) - 0.5
        decay = jnp.exp(-jnp.exp(heads(logw)))
        a = heads(jax.nn.sigmoid(icl0[d] + (xa @ icl1[d]) @ icl2[d]))
        k_d = k_h * (1.0 + (a - 1.0) * k_a_h)
        k_dirs.append(k_d)
        seq = tuple(jnp.swapaxes(t, 0, 1) for t in (r_h, decay, k_d, v_h, -kk, kk * a))
        rev = d == 1
        s_ctx, y_c = wkv_scan(state0, tuple(t[:L] for t in seq), rev, emit_ctx)
        _, y_l = wkv_scan(s_ctx, tuple(t[L:] for t in seq), rev, True)
        y_lat_dirs.append(y_l)
        y_ctx_dirs.append(y_c)
    y_lat = y_lat_dirs[0] + y_lat_dirs[1]
    if emit_ctx:
        y = jnp.concatenate([y_ctx_dirs[0] + y_ctx_dirs[1], y_lat], 0)
        lo = 0
    else:
        y = y_lat
        lo = L
    y = jnp.swapaxes(y, 0, 1)
    ym = jnp.mean(y, -1, keepdims=True)
    yv = jnp.mean(jnp.square(y - ym), -1, keepdims=True)
    n_out = y.shape[1]
    yn = ((y - ym) * lax.rsqrt(yv + LNX_EPS)).reshape(Bn, n_out, D) * lnx[0] + lnx[1]
    k_sum = k_dirs[0] + k_dirs[1]
    bonus = jnp.sum(r_h[:, lo:] * k_sum[:, lo:] * r_k, -1, keepdims=True) * v_h[:, lo:]
    o = ((yn + bonus.reshape(Bn, n_out, D)).astype(u.dtype) * g[:, lo:]) @ w_out
    if emit_ctx:
        return o[:, :L], o[:, L:]
    return None, o


def moe_ffn(u, router, bias, w_in, w_out, ws_in, ws_out):
    Bn, N, D = u.shape
    T = Bn * N
    xt = u.reshape(T, D)
    scores = jax.nn.sigmoid((xt @ router).astype(jnp.float32))
    sel = scores + bias.astype(jnp.float32)
    per_group = N_EXPERTS // N_GROUPS
    grp_score = lax.top_k(sel.reshape(T, N_GROUPS, per_group), 2)[0].sum(-1)
    _, gidx = lax.top_k(grp_score, TOPK_GROUPS)
    gmask = jnp.any(gidx[:, :, None] == jnp.arange(N_GROUPS)[None, None, :], axis=1)
    sel = jnp.where(jnp.repeat(gmask, per_group, axis=1), sel, NEG_INF)
    _, eidx = lax.top_k(sel, TOP_K)
    gw = jnp.take_along_axis(scores, eidx, axis=1)
    gw = gw / jnp.sum(gw, -1, keepdims=True) * ROUTED_SCALE
    TK = T * TOP_K
    flat_e = eidx.reshape(-1)
    order = jnp.argsort(flat_e)
    sorted_e = flat_e[order]
    counts = jnp.bincount(flat_e, length=N_EXPERTS)
    padded = (counts + MOE_BLOCK - 1) // MOE_BLOCK * MOE_BLOCK
    start = jnp.cumsum(counts) - counts
    pstart = jnp.cumsum(padded) - padded
    dest = pstart[sorted_e] + jnp.arange(TK) - start[sorted_e]
    n_blocks = -(-(TK + N_EXPERTS * (MOE_BLOCK - 1)) // MOE_BLOCK)
    P = n_blocks * MOE_BLOCK
    row_tok = jnp.full((P,), T, jnp.int32).at[dest].set((order // TOP_K).astype(jnp.int32))
    row_w = jnp.zeros((P,), jnp.float32).at[dest].set(gw.reshape(-1)[order])
    block_exp = jnp.minimum(
        jnp.searchsorted(jnp.cumsum(padded), jnp.arange(n_blocks) * MOE_BLOCK, side='right'),
        N_EXPERTS - 1)
    x_pad = jnp.concatenate([xt, jnp.zeros((1, D), xt.dtype)], 0)

    def block(acc, blk):
        rows, e, rw = blk
        xb = x_pad[rows]
        gate, up = jnp.split(xb @ w_in[e], 2, axis=-1)
        out = (jax.nn.silu(gate) * up) @ w_out[e]
        return acc.at[rows].add(out.astype(jnp.float32) * rw[:, None]), None

    acc, _ = lax.scan(block, jnp.zeros((T + 1, D), jnp.float32),
                      (row_tok.reshape(n_blocks, MOE_BLOCK), block_exp, row_w.reshape(n_blocks, MOE_BLOCK)))
    sg, su = jnp.split(xt @ ws_in, 2, axis=-1)
    shared = (jax.nn.silu(sg) * su) @ ws_out
    return (acc[:T].astype(u.dtype) + shared).reshape(Bn, N, D)


def setup_inputs(seed: int = 0) -> dict:
    key = jax.random.key(seed)
    ks = iter(jax.random.split(key, 64))
    f32 = jnp.float32
    D = D_MODEL
    sd = D ** -0.5
    beta = DEEPNORM_BETA

    def nrm(shape, scale):
        return jax.random.normal(next(ks), shape, f32) * scale

    x = nrm((BATCH, SEQ, D), 1.0)
    c = nrm((BATCH, D), 1.0)
    ctx = nrm((BATCH, CTX_LEN, D), 1.0)
    c_ctx = nrm((D,), 1.0)
    ada_w = nrm((DEPTH, D, 6 * D), 0.5 * sd)
    ada_b = nrm((DEPTH, 6 * D), 0.02)
    post_ln_g = 1.0 + nrm((DEPTH, 2, D), 0.02)
    post_ln_b = nrm((DEPTH, 2, D), 0.02)
    att_w_in = jnp.concatenate([
        nrm((N_ATT, D, IN_SIZES[0]), sd),
        nrm((N_ATT, D, IN_SIZES[1]), sd),
        nrm((N_ATT, D, IN_SIZES[2]), sd * beta),
        nrm((N_ATT, D, IN_SIZES[3]), sd),
        nrm((N_ATT, D, IN_SIZES[4]), sd),
        nrm((N_ATT, D, IN_SIZES[5]), sd * beta)], axis=-1)
    att_w_out = nrm((N_ATT, A_WIDTH + B_WIDTH, D), (A_WIDTH + B_WIDTH) ** -0.5 * beta)
    att_sink = nrm((N_ATT, A_KV_HEADS, A_GROUP), 0.5)
    diff_lambda_vecs = nrm((N_ATT, 4, HEAD_DIM), 0.1)
    diff_subln_g = 1.0 + nrm((N_ATT, B_V_DIM), 0.02)
    rk_mu = jax.random.uniform(next(ks), (N_RWKV, 6, D), f32, 0.2, 0.8)
    rk_w_rkv = nrm((N_RWKV, 3, D, D), sd) * jnp.array([1.0, 1.0, beta], f32)[:, None, None]
    rk_w_out = nrm((N_RWKV, D, D), sd * beta)
    ramp = -6.5 + 5.0 * (jnp.arange(D, dtype=f32) / (D - 1)) ** 0.85
    rk_decay0 = ramp + nrm((N_RWKV, 2, D), 0.1)
    rk_decay1 = nrm((N_RWKV, 2, D, DECAY_LORA), sd)
    rk_decay2 = nrm((N_RWKV, 2, DECAY_LORA, D), 0.1 * DECAY_LORA ** -0.5)
    rk_iclr0 = nrm((N_RWKV, 2, D), 0.1)
    rk_iclr1 = nrm((N_RWKV, 2, D, ICLR_LORA), sd)
    rk_iclr2 = nrm((N_RWKV, 2, ICLR_LORA, D), 0.5 * ICLR_LORA ** -0.5)
    rk_gate1 = nrm((N_RWKV, D, GATE_LORA), sd)
    rk_gate2 = nrm((N_RWKV, GATE_LORA, D), GATE_LORA ** -0.5)
    rk_k_k = 0.85 + nrm((N_RWKV, D), 0.02)
    rk_k_a = 1.0 + nrm((N_RWKV, D), 0.02)
    rk_r_k = -0.04 + nrm((N_RWKV, RW_HEADS, HEAD_DIM), 0.02)
    rk_lnx = jnp.stack([1.0 + nrm((N_RWKV, D), 0.02), nrm((N_RWKV, D), 0.02)], axis=1)
    moe_router = nrm((DEPTH, D, N_EXPERTS), sd)
    moe_bias = nrm((DEPTH, N_EXPERTS), 0.01)
    moe_w_in = nrm((DEPTH, N_EXPERTS, D, 2 * EXPERT_FF), sd * beta)
    moe_w_out = nrm((DEPTH, N_EXPERTS, EXPERT_FF, D), EXPERT_FF ** -0.5 * beta)
    moe_ws_in = nrm((DEPTH, D, 2 * SHARED_FF), sd * beta)
    moe_ws_out = nrm((DEPTH, SHARED_FF, D), SHARED_FF ** -0.5 * beta)
    return {'x': x, 'c': c, 'ctx': ctx, 'c_ctx': c_ctx,
            'ada_w': ada_w, 'ada_b': ada_b, 'post_ln_g': post_ln_g, 'post_ln_b': post_ln_b,
            'att_w_in': att_w_in, 'att_w_out': att_w_out, 'att_sink': att_sink,
            'diff_lambda_vecs': diff_lambda_vecs, 'diff_subln_g': diff_subln_g,
            'rk_mu': rk_mu, 'rk_w_rkv': rk_w_rkv, 'rk_w_out': rk_w_out,
            'rk_decay0': rk_decay0, 'rk_decay1': rk_decay1, 'rk_decay2': rk_decay2,
            'rk_iclr0': rk_iclr0, 'rk_iclr1': rk_iclr1, 'rk_iclr2': rk_iclr2,
            'rk_gate1': rk_gate1, 'rk_gate2': rk_gate2, 'rk_k_k': rk_k_k, 'rk_k_a': rk_k_a,
            'rk_r_k': rk_r_k, 'rk_lnx': rk_lnx,
            'moe_router': moe_router, 'moe_bias': moe_bias, 'moe_w_in': moe_w_in,
            'moe_w_out': moe_w_out, 'moe_ws_in': moe_ws_in, 'moe_ws_out': moe_ws_out}


def reference(x, c, ctx, c_ctx, ada_w, ada_b, post_ln_g, post_ln_b,
              att_w_in, att_w_out, att_sink, diff_lambda_vecs, diff_subln_g,
              rk_mu, rk_w_rkv, rk_w_out, rk_decay0, rk_decay1, rk_decay2,
              rk_iclr0, rk_iclr1, rk_iclr2, rk_gate1, rk_gate2, rk_k_k, rk_k_a, rk_r_k, rk_lnx,
              moe_router, moe_bias, moe_w_in, moe_w_out, moe_ws_in, moe_ws_out):
    S = x.shape[1]
    L = ctx.shape[1]
    cos, sin = axial_rope(S)
    c_act = jax.nn.silu(c)
    cc_act = jax.nn.silu(c_ctx)
    h_lat, h_ctx = x, ctx
    for i in range(DEPTH):
        last = i == DEPTH - 1
        j = i // 2
        m_lat = jnp.split((c_act @ ada_w[i] + ada_b[i])[:, None, :], 6, axis=-1)
        m_ctx = jnp.split(cc_act @ ada_w[i] + ada_b[i], 6, axis=-1)
        u_lat = modulate(h_lat, m_lat[0], m_lat[1])
        u_ctx = modulate(h_ctx, m_ctx[0], m_ctx[1])
        if i % 2 == 0:
            lam_init = 0.8 - 0.6 * math.exp(-0.3 * i)
            o_ctx, o_lat = attn_mixer(u_ctx, u_lat, att_w_in[j], att_w_out[j], att_sink[j],
                                      diff_lambda_vecs[j], diff_subln_g[j], lam_init, cos, sin,
                                      not last)
        else:
            o_ctx, o_lat = rwkv7_bidir_mixer(u_ctx, u_lat, rk_mu[j], rk_w_rkv[j], rk_w_out[j],
                                             rk_decay0[j], rk_decay1[j], rk_decay2[j],
                                             rk_iclr0[j], rk_iclr1[j], rk_iclr2[j],
                                             rk_gate1[j], rk_gate2[j], rk_k_k[j], rk_k_a[j],
                                             rk_r_k[j], rk_lnx[j], not last)
        h_lat = layer_norm(DEEPNORM_ALPHA * h_lat + m_lat[2] * o_lat, post_ln_g[i, 0], post_ln_b[i, 0])
        u_lat = modulate(h_lat, m_lat[3], m_lat[4])
        if last:
            f_lat = moe_ffn(u_lat, moe_router[i], moe_bias[i], moe_w_in[i], moe_w_out[i],
                            moe_ws_in[i], moe_ws_out[i])
        else:
            h_ctx = layer_norm(DEEPNORM_ALPHA * h_ctx + m_ctx[2] * o_ctx, post_ln_g[i, 0], post_ln_b[i, 0])
            u_ctx = modulate(h_ctx, m_ctx[3], m_ctx[4])
            f = moe_ffn(jnp.concatenate([u_ctx, u_lat], 1), moe_router[i], moe_bias[i],
                        moe_w_in[i], moe_w_out[i], moe_ws_in[i], moe_ws_out[i])
            f_ctx, f_lat = f[:, :L], f[:, L:]
            h_ctx = layer_norm(DEEPNORM_ALPHA * h_ctx + m_ctx[5] * f_ctx, post_ln_g[i, 1], post_ln_b[i, 1])
        h_lat = layer_norm(DEEPNORM_ALPHA * h_lat + m_lat[5] * f_lat, post_ln_g[i, 1], post_ln_b[i, 1])
    return h_lat
```

```cpp
#include <hip/hip_runtime.h>
#include <cstdio>
#include <cstdint>

#ifndef MK_ONE_LAUNCH
#define MK_ONE_LAUNCH 1
#endif

typedef unsigned short u16;
typedef short s16x8 __attribute__((ext_vector_type(8)));
typedef short s16x4 __attribute__((ext_vector_type(4)));
typedef short v4i16_t __attribute__((ext_vector_type(4)));
typedef float f32x4 __attribute__((ext_vector_type(4)));
typedef float f32x2 __attribute__((ext_vector_type(2)));
typedef unsigned u32x4 __attribute__((ext_vector_type(4)));
typedef unsigned u32x2 __attribute__((ext_vector_type(2)));
typedef int i32x4 __attribute__((ext_vector_type(4)));
typedef __bf16 bf16x2_t __attribute__((ext_vector_type(2)));
#define LAS __attribute__((address_space(3)))
#define DI __device__ __forceinline__
typedef LAS unsigned char* ldsp;

#define XB_TMO      128
#define XB_XCNT(j)  (256  + 64 * (j))
#define XB_XSUB(j)  (1280 + 64 * (j))
#define XB_XGEN(j)  (2304 + 64 * (j))
#define XB_TOP      3328
#define XB_TOPGEN   3392
#define XCD_BAR_WORDS 3456
#define XB_SPIN_CAP (1u << 18)

__device__ __forceinline__ unsigned xb_ld(unsigned* p)              { return __hip_atomic_load(p, __ATOMIC_RELAXED, __HIP_MEMORY_SCOPE_AGENT); }
__device__ __forceinline__ unsigned xb_add(unsigned* p, unsigned v) { return __hip_atomic_fetch_add(p, v, __ATOMIC_RELAXED, __HIP_MEMORY_SCOPE_AGENT); }
__device__ __forceinline__ unsigned xb_xcc_id() { return (unsigned)__builtin_amdgcn_s_getreg((3 << 11) | 20) & 0xFu; }
#define XB_SPIN(cond, bar) do { unsigned _sp = 0; while (cond) { __builtin_amdgcn_s_sleep(1); \
    if ((++_sp & 255u) == 0u) { if (xb_ld(&(bar)[XB_TMO])) break; if (_sp > XB_SPIN_CAP) { atomicAdd(&(bar)[XB_TMO], 1u); break; } } } } while (0)

struct XcdBarrier {
    unsigned* bar; unsigned x;
    volatile LAS unsigned* st;
};

__device__ __forceinline__ XcdBarrier xcd_barrier_post(unsigned* bar, volatile LAS unsigned* st) {
    XcdBarrier b; b.bar = bar; b.x = xb_xcc_id(); b.st = st;
    if (threadIdx.x == 0) (void)xb_add(&bar[XB_XCNT(b.x)], 1u);
    return b;
}
__device__ __forceinline__ void xcd_barrier_complete(unsigned* bar, unsigned x, unsigned& nloc, unsigned& nx) {
    const unsigned G = gridDim.x * gridDim.y * gridDim.z;
    unsigned sum, cnt, mine, sp = 0u;
    for (;;) {
        sum = 0u; cnt = 0u; mine = 0u;
#pragma unroll
        for (unsigned j = 0; j < 16; ++j) { const unsigned c = xb_ld(&bar[XB_XCNT(j)]); sum += c; cnt += (c > 0u) ? 1u : 0u; mine = (j == x) ? c : mine; }
        if (sum == G) break;
        __builtin_amdgcn_s_sleep(1);
        if ((++sp & 255u) == 0u) { if (xb_ld(&bar[XB_TMO])) break; if (sp > XB_SPIN_CAP) { atomicAdd(&bar[XB_TMO], 1u); break; } }
    }
    nloc = mine > 0u ? mine : 1u; nx = cnt > 0u ? cnt : 1u;
}

__device__ __forceinline__ void xcd_barrier(const XcdBarrier& b) {
    asm volatile("s_waitcnt vmcnt(0)" ::: "memory");
    __syncthreads();
    if (threadIdx.x == 0) {
        unsigned* bar = b.bar;
        __builtin_amdgcn_s_waitcnt(0);
        unsigned nloc = b.st[0], nx = b.st[1];
        if (nloc == 0u) { xcd_barrier_complete(bar, b.x, nloc, nx); b.st[0] = nloc; b.st[1] = nx; }
        const unsigned old = xb_add(&bar[XB_XSUB(b.x)], 1u);
        const unsigned gen = old / nloc;
        if (old + 1u == (gen + 1u) * nloc) {
            __builtin_amdgcn_fence(__ATOMIC_RELEASE, "agent");
            asm volatile("s_waitcnt vmcnt(0)" ::: "memory");
            const unsigned og = xb_add(&bar[XB_TOP], 1u);
            const unsigned tg = og / nx;
            if (og + 1u == (tg + 1u) * nx) xb_add(&bar[XB_TOPGEN], 1u);
            else XB_SPIN(xb_ld(&bar[XB_TOPGEN]) == tg, bar);
            __builtin_amdgcn_fence(__ATOMIC_ACQUIRE, "agent");
            xb_add(&bar[XB_XGEN(b.x)], 1u);
            asm volatile("s_waitcnt vmcnt(0)" ::: "memory");
        } else {
            XB_SPIN(xb_ld(&bar[XB_XGEN(b.x)]) == gen, bar);
            __builtin_amdgcn_fence(__ATOMIC_ACQUIRE, "agent");
            asm volatile("s_waitcnt vmcnt(0)" ::: "memory");
        }
    }
    __syncthreads();
}

constexpr int D = 1024, NBATCH = 8, SEQ = 2048, CTXL = 256, NTOK = 2304;
constexpr int T = NBATCH * NTOK;
constexpr int TL = NBATCH * SEQ;
constexpr int HPW = 2304;
constexpr float ALPHA = 1.41421356237309515f;
constexpr float LN_EPS = 1e-5f;
constexpr float L2E = 1.4426950408889634f;
constexpr int NTHR = 512;

constexpr size_t al256(size_t x) { return (x + 255) & ~(size_t)255; }
constexpr size_t WS_CTL  = 0;
constexpr int CNT_STR = 64;
constexpr size_t CTL_CNT = 16384;
constexpr size_t CTL_BYTES = CTL_CNT + (size_t)2 * 256 * CNT_STR * 4;
constexpr size_t WS_MODS = WS_CTL + CTL_BYTES;
constexpr size_t WS_H    = al256(WS_MODS + 2 * 9 * 6144 * 4);
constexpr size_t WS_U    = al256(WS_H + (size_t)T * D * 4);
constexpr size_t WS_HP   = al256(WS_U + (size_t)T * D * 2);
constexpr size_t WS_AO   = al256(WS_HP + (size_t)T * HPW * 2);
constexpr size_t WS_Z    = al256(WS_AO + (size_t)T * D * 2);
constexpr size_t WS_ACC  = al256(WS_Z + (size_t)T * D * 4);
constexpr size_t WS_SC   = al256(WS_ACC + (size_t)T * D * 4);
constexpr size_t WS_EIDX = al256(WS_SC + (size_t)T * 256 * 4);
constexpr size_t WS_GW   = al256(WS_EIDX + (size_t)T * 8 * 4);
constexpr size_t WS_EPOS = al256(WS_GW + (size_t)T * 8 * 4);
constexpr size_t WS_RTOK = al256(WS_EPOS + (size_t)T * 8 * 4);
constexpr size_t WS_RW   = al256(WS_RTOK + (size_t)T * 8 * 4);
constexpr size_t WS_XMIX = al256(WS_RW + (size_t)T * 8 * 4);
constexpr size_t WS_R    = al256(WS_XMIX + (size_t)6 * T * D * 2);
constexpr size_t WS_K    = al256(WS_R + (size_t)T * D * 4);
constexpr size_t WS_V    = al256(WS_K + (size_t)T * D * 4);
constexpr size_t WS_KK   = al256(WS_V + (size_t)T * D * 4);
constexpr size_t WS_W0   = al256(WS_KK + (size_t)T * D * 4);
constexpr size_t WS_A0   = al256(WS_W0 + (size_t)2 * T * D * 4);
constexpr size_t WS_G    = al256(WS_A0 + (size_t)2 * T * D * 4);
constexpr size_t WS_LW   = al256(WS_G + (size_t)T * D * 4);
constexpr size_t WS_LA   = al256(WS_LW + (size_t)T * 128 * 2);
constexpr size_t WS_SG   = al256(WS_LA + (size_t)T * 128 * 2);
constexpr size_t WS_Y    = al256(WS_SG + (size_t)T * 192 * 2);
constexpr size_t WS_SLOT = al256(WS_Y + (size_t)2 * TL * D * 4);
constexpr size_t WS_SH   = al256(WS_SLOT + (size_t)T * 8 * D * 2);
constexpr size_t WB_WIN  = al256(WS_SH + (size_t)T * D * 2);
constexpr size_t WB_WOUT = al256(WB_WIN + (size_t)1024 * 2304 * 2);
constexpr size_t WB_RKV  = al256(WB_WOUT + (size_t)1024 * 1024 * 2);
constexpr size_t WB_RKO  = al256(WB_RKV + (size_t)3 * 1024 * 1024 * 2);
constexpr size_t WB_RT   = al256(WB_RKO + (size_t)1024 * 1024 * 2);
constexpr size_t WB_DEC1 = al256(WB_RT + (size_t)2 * 1024 * 256 * 2);
constexpr size_t WB_ICL1 = al256(WB_DEC1 + (size_t)1024 * 256 * 2);
constexpr size_t WB_G1   = al256(WB_ICL1 + (size_t)1024 * 256 * 2);
constexpr size_t WB_DEC2 = al256(WB_G1 + (size_t)1024 * 256 * 2);
constexpr size_t WB_ICL2 = al256(WB_DEC2 + (size_t)2 * 64 * 1024 * 2);
constexpr size_t WB_G2   = al256(WB_ICL2 + (size_t)2 * 64 * 1024 * 2);
constexpr size_t WB_EIN  = al256(WB_G2 + (size_t)192 * 1024 * 2);
constexpr size_t WB_EOUT = al256(WB_EIN + (size_t)2 * 256 * 1024 * 512 * 2);
constexpr size_t WB_SIN  = al256(WB_EOUT + (size_t)2 * 256 * 256 * 1024 * 2);
constexpr size_t WB_SOUT = al256(WB_SIN + (size_t)2 * 1024 * 512 * 2);
constexpr int NPMAX = T * 8 + 256 * 256;
constexpr size_t WT_IN   = al256(WB_SOUT + (size_t)2 * 256 * 1024 * 2);
constexpr size_t WT_OUT  = al256(WT_IN + (size_t)2 * 257 * 512 * 1024 * 2);
constexpr size_t WS_HG   = al256(WT_OUT + (size_t)2 * 257 * 1024 * 256 * 2);
constexpr size_t WS_AROW = al256(WS_HG + (size_t)(NPMAX + T) * 256 * 2);
constexpr size_t WS_RTK2 = al256(WS_AROW + (size_t)NPMAX * 4);
constexpr size_t WS_RW2  = al256(WS_RTK2 + (size_t)NPMAX * 4);
constexpr size_t WS_END  = al256(WS_RW2 + (size_t)NPMAX * 4);

constexpr int LDS_BASE = 256;
constexpr int A_STR = 144;
constexpr int B_STR = 528;
constexpr int LDS_AS = LDS_BASE;
constexpr int LDS_BS = LDS_AS + 128 * A_STR;
constexpr int LDS_HS = LDS_BS + 64 * B_STR;
constexpr int LDS_MISC = LDS_HS + 128 * B_STR;
constexpr int LDS_BYTES = 152 * 1024;

struct Params {
    const float* in[34];
    float* out;
    unsigned char* ws;
    int ph_lo, ph_hi;
};

DI float bf2f(u16 x) { return __uint_as_float(((unsigned)x) << 16); }
DI unsigned pack2(float a, float b) { f32x2 v = {a, b}; bf16x2_t r = __builtin_convertvector(v, bf16x2_t); return __builtin_bit_cast(unsigned, r); }
DI u16 f2bf(float a) { return (u16)(pack2(a, 0.f) & 0xffffu); }
DI s16x4 vtr(const LAS unsigned char* p) { return __builtin_bit_cast(s16x4, __builtin_amdgcn_ds_read_tr16_b64_v4i16((LAS v4i16_t*)p)); }
DI float sigmoidf_(float x) { return 1.f / (1.f + __expf(-x)); }
DI float siluf_(float x) { return x / (1.f + __expf(-x)); }
DI float wsum64(float v) { v += __shfl_xor(v, 32); v += __shfl_xor(v, 16); v += __shfl_xor(v, 8); v += __shfl_xor(v, 4); v += __shfl_xor(v, 2); v += __shfl_xor(v, 1); return v; }
DI float wsum16(float v) { v += __shfl_xor(v, 8); v += __shfl_xor(v, 4); v += __shfl_xor(v, 2); v += __shfl_xor(v, 1); return v; }
DI const float* mods_ptr(const Params& p, int layer, int mrow, int j) { return (const float*)(p.ws + WS_MODS) + ((size_t)(layer * 9 + mrow) * 6 + j) * 1024; }
DI f32x4 ld_bf4(const u16* p) { const u32x2 v = *(const u32x2*)p; return (f32x4){bf2f((u16)(v[0] & 0xffffu)), bf2f((u16)(v[0] >> 16)), bf2f((u16)(v[1] & 0xffffu)), bf2f((u16)(v[1] >> 16))}; }
DI int modrow_of(int row) { int b = row / NTOK; int n = row - b * NTOK; return n < CTXL ? 8 : b; }

template <int ASTR>
DI void mma_ktile(f32x4 (&acc)[4][4], const LAS unsigned char* a_ptr, const LAS unsigned char* b_ptr) {
#pragma unroll
    for (int ks = 0; ks < 2; ++ks) {
        s16x8 a[4], b[4];
#pragma unroll
        for (int mt = 0; mt < 4; ++mt) a[mt] = *(const LAS s16x8*)(a_ptr + mt * 16 * ASTR + ks * 64);
#pragma unroll
        for (int nt = 0; nt < 4; ++nt) {
            s16x4 lo = vtr(b_ptr + ks * 32 * B_STR + nt * 32);
            s16x4 hi = vtr(b_ptr + ks * 32 * B_STR + 4 * B_STR + nt * 32);
            b[nt] = (s16x8){lo[0], lo[1], lo[2], lo[3], hi[0], hi[1], hi[2], hi[3]};
        }
#pragma unroll
        for (int mt = 0; mt < 4; ++mt)
#pragma unroll
            for (int nt = 0; nt < 4; ++nt)
                acc[mt][nt] = __builtin_amdgcn_mfma_f32_16x16x32_bf16(a[mt], b[nt], acc[mt][nt], 0, 0, 0);
    }
}

template <bool HAS_A, int ASTR, class ALoad, class BLoad>
DI void gemm_kloop(ldsp lds, int nkt, const ALoad& aload, const BLoad& bload, f32x4 (&acc)[4][4], const LAS unsigned char* a_res) {
    const int tid = threadIdx.x, lane = tid & 63, wave = tid >> 6, wr = wave >> 2, wc = wave & 3;
    ldsp As = lds + LDS_AS; ldsp Bs = lds + LDS_BS;
    const LAS unsigned char* a_ptr = HAS_A ? (As + (wr * 64 + (lane & 15)) * ASTR + (lane >> 4) * 16)
                                           : (a_res + (wr * 64 + (lane & 15)) * ASTR + (lane >> 4) * 16);
    const LAS unsigned char* b_ptr = Bs + (8 * (lane >> 4) + ((lane >> 2) & 3)) * B_STR + (wc * 64 + 4 * (lane & 3)) * 2;
    u32x4 ra[2]; f32x4 rb[8];
    if (HAS_A) {
#pragma unroll
        for (int s = 0; s < 2; ++s) { int c = tid + 512 * s; ra[s] = aload(c >> 3, (c & 7) * 8); }
    }
#pragma unroll
    for (int s = 0; s < 8; ++s) rb[s] = bload(wave + 8 * s, lane * 4);
    for (int kt = 0; kt < nkt; ++kt) {
        __syncthreads();
        if (HAS_A) {
#pragma unroll
            for (int s = 0; s < 2; ++s) { int c = tid + 512 * s; *(LAS u32x4*)(As + (c >> 3) * ASTR + (c & 7) * 16) = ra[s]; }
        }
#pragma unroll
        for (int s = 0; s < 8; ++s) {
            u32x2 v; v[0] = pack2(rb[s][0], rb[s][1]); v[1] = pack2(rb[s][2], rb[s][3]);
            *(LAS u32x2*)(Bs + (wave + 8 * s) * B_STR + lane * 8) = v;
        }
        __syncthreads();
        {
            const int k0 = ((kt + 1 < nkt) ? kt + 1 : kt) * 64;
            if (HAS_A) {
#pragma unroll
                for (int s = 0; s < 2; ++s) { int c = tid + 512 * s; ra[s] = aload(c >> 3, k0 + (c & 7) * 8); }
            }
#pragma unroll
            for (int s = 0; s < 8; ++s) rb[s] = bload(k0 + wave + 8 * s, lane * 4);
        }
        mma_ktile<ASTR>(acc, a_ptr + (HAS_A ? 0 : kt * 128), b_ptr);
    }
}

template <class ALoad, class BLoad16>
DI void gemm_kloop16(ldsp lds, int nkt, const ALoad& aload, const BLoad16& bload, f32x4 (&acc)[4][4]) {
    const int tid = threadIdx.x, lane = tid & 63, wave = tid >> 6, wr = wave >> 2, wc = wave & 3;
    ldsp As = lds + LDS_AS; ldsp Bs = lds + LDS_BS;
    const LAS unsigned char* a_ptr = As + (wr * 64 + (lane & 15)) * A_STR + (lane >> 4) * 16;
    const LAS unsigned char* b_ptr = Bs + (8 * (lane >> 4) + ((lane >> 2) & 3)) * B_STR + (wc * 64 + 4 * (lane & 3)) * 2;
    const int bk = tid >> 5, bc = (tid & 31) * 8;
    u32x4 ra0[2], ra1[2], rb0[4], rb1[4];
#define GK_LOAD(RA, RB, KT) do { const int k0_ = (KT) * 64; \
        _Pragma("unroll") for (int s_ = 0; s_ < 2; ++s_) { const int c_ = tid + 512 * s_; RA[s_] = aload(c_ >> 3, k0_ + (c_ & 7) * 8); } \
        _Pragma("unroll") for (int s_ = 0; s_ < 4; ++s_) RB[s_] = bload(k0_ + bk + 16 * s_, bc); } while (0)
#define GK_STEP(RA, RB, KT) do { \
        __syncthreads(); \
        _Pragma("unroll") for (int s_ = 0; s_ < 2; ++s_) { const int c_ = tid + 512 * s_; *(LAS u32x4*)(As + (c_ >> 3) * A_STR + (c_ & 7) * 16) = RA[s_]; } \
        _Pragma("unroll") for (int s_ = 0; s_ < 4; ++s_) *(LAS u32x4*)(Bs + (bk + 16 * s_) * B_STR + bc * 2) = RB[s_]; \
        __syncthreads(); \
        if ((KT) + 2 < nkt) GK_LOAD(RA, RB, (KT) + 2); \
        mma_ktile<A_STR>(acc, a_ptr, b_ptr); } while (0)
    GK_LOAD(ra0, rb0, 0);
    if (nkt > 1) GK_LOAD(ra1, rb1, 1);
    for (int kt = 0; kt < nkt; kt += 2) {
        GK_STEP(ra0, rb0, kt);
        if (kt + 1 < nkt) GK_STEP(ra1, rb1, kt + 1);
    }
#undef GK_LOAD
#undef GK_STEP
}

template <bool HAS_A, int ASTR, class ALoad, class BLoad16>
DI void gemm_kloop16(ldsp lds, int nkt, const ALoad& aload, const BLoad16& bload, f32x4 (&acc)[4][4], const LAS unsigned char* a_res) {
    const int tid = threadIdx.x, lane = tid & 63, wave = tid >> 6, wr = wave >> 2, wc = wave & 3;
    ldsp As = lds + LDS_AS; ldsp Bs = lds + LDS_BS;
    const LAS unsigned char* a_ptr = HAS_A ? (As + (wr * 64 + (lane & 15)) * ASTR + (lane >> 4) * 16)
                                           : (a_res + (wr * 64 + (lane & 15)) * ASTR + (lane >> 4) * 16);
    const LAS unsigned char* b_ptr = Bs + (8 * (lane >> 4) + ((lane >> 2) & 3)) * B_STR + (wc * 64 + 4 * (lane & 3)) * 2;
    const int bk = tid >> 5, bc = (tid & 31) * 8;
    u32x4 ra0[2], ra1[2], rb0[4], rb1[4];
#define GK_LOAD(RA, RB, KT) do { const int k0_ = (KT) * 64; \
        if (HAS_A) { _Pragma("unroll") for (int s_ = 0; s_ < 2; ++s_) { const int c_ = tid + 512 * s_; RA[s_] = aload(c_ >> 3, k0_ + (c_ & 7) * 8); } } \
        _Pragma("unroll") for (int s_ = 0; s_ < 4; ++s_) RB[s_] = bload(k0_ + bk + 16 * s_, bc); } while (0)
#define GK_STEP(RA, RB, KT) do { \
        __syncthreads(); \
        if (HAS_A) { _Pragma("unroll") for (int s_ = 0; s_ < 2; ++s_) { const int c_ = tid + 512 * s_; *(LAS u32x4*)(As + (c_ >> 3) * ASTR + (c_ & 7) * 16) = RA[s_]; } } \
        _Pragma("unroll") for (int s_ = 0; s_ < 4; ++s_) *(LAS u32x4*)(Bs + (bk + 16 * s_) * B_STR + bc * 2) = RB[s_]; \
        __syncthreads(); \
        GK_LOAD(RA, RB, ((KT) + 2 < nkt) ? (KT) + 2 : nkt - 1); \
        mma_ktile<ASTR>(acc, a_ptr + (HAS_A ? 0 : (KT) * 128), b_ptr); } while (0)
    GK_LOAD(ra0, rb0, 0);
    GK_LOAD(ra1, rb1, (nkt > 1) ? 1 : 0);
    for (int kt = 0; kt < nkt; kt += 2) {
        GK_STEP(ra0, rb0, kt);
        GK_STEP(ra1, rb1, kt + 1);
    }
#undef GK_LOAD
#undef GK_STEP
}

struct ALoadDense {
    const u16* base; int lda;
    DI u32x4 operator()(int r, int k) const { return *(const u32x4*)(base + (size_t)r * lda + k); }
};
struct ALoadNone { DI u32x4 operator()(int, int) const { return (u32x4){0, 0, 0, 0}; } };
struct BLoadDense {
    const float* W; int ldw; int K; int ncols;
    DI f32x4 operator()(int k, int c) const {
        f32x4 z = {0.f, 0.f, 0.f, 0.f};
        if (k < K && c < ncols) z = *(const f32x4*)(W + (size_t)k * ldw + c);
        return z;
    }
};
struct BLoadDenseU {
    const float* W; int ldw;
    DI f32x4 operator()(int k, int c) const { return *(const f32x4*)(W + (size_t)k * ldw + c); }
};
struct BLoad16U {
    const u16* W; int ldw;
    DI u32x4 operator()(int k, int c) const { return *(const u32x4*)(W + (size_t)k * ldw + c); }
};
struct BLoadDual {
    const float* W0; const float* W1;
    DI f32x4 operator()(int k, int c) const {
        f32x4 z = {0.f, 0.f, 0.f, 0.f};
        if (c < 64) z = *(const f32x4*)(W0 + (size_t)k * 64 + c);
        else if (c < 128) z = *(const f32x4*)(W1 + (size_t)k * 64 + (c - 64));
        return z;
    }
};

struct BLoad16Dense {
    const u16* W; int ldw; int K; int ncols;
    DI u32x4 operator()(int k, int c) const {
        u32x4 z = {0u, 0u, 0u, 0u};
        if (k < K && c < ncols) z = *(const u32x4*)(W + (size_t)k * ldw + c);
        return z;
    }
};
struct RowAll { DI int operator()(int m0) const { return m0; } };
struct RowLat { DI int operator()(int m0) const { return (m0 >> 11) * NTOK + CTXL + (m0 & 2047); } };

constexpr int LDS_A3 = LDS_BASE;
constexpr int LDS_B3 = LDS_A3 + 2 * 128 * A_STR;
constexpr int LDS_T3 = LDS_B3 + 2 * 256 * A_STR;
constexpr int T3_STR = 272, T3_SZ = 16 * T3_STR;
constexpr int LDS_TAB3 = LDS_T3 + 8 * T3_SZ;
static_assert(LDS_TAB3 + 8192 <= LDS_BYTES, "v3 LDS map");
constexpr int LDS_PG8_TAB = LDS_BASE + 8 * 128 * 64 * 2;
static_assert(LDS_PG8_TAB + 8192 <= LDS_BYTES, "pg8 LDS map");
struct BtDesc { const u16* Bt; int ldb, K, N; };
template <class RowMap, class Epi>
DI void gemm_phase(ldsp lds, const u16* A, int lda, int M, const BtDesc bd, const RowMap& rmap, const Epi& epi, int first_ = -1, int stride_ = 0) {
    const int tid = threadIdx.x, lane = tid & 63, wave = tid >> 6, wr = wave >> 2, wc = wave & 3, g = lane >> 4;
    const int G = first_ < 0 ? (int)gridDim.x : stride_;
    const int ntn = (bd.N + 255) >> 8, ntm = M >> 7, nkt = (bd.K + 63) >> 6, ntiles = ntm * ntn;
    const int first = first_ < 0 ? (int)blockIdx.x : first_;
    if (first >= ntiles) return;
    const int S = ((ntiles - first + G - 1) / G) * nkt;
    int l_tile = first, l_kt = 0;
    int c_tile = first, c_kt = 0;
    u32x4 ra0[2], ra1[2], rb0[4], rb1[4];
#define V3_LOAD(RA, RB) do { \
        const int tm_ = l_tile / ntn, tn_ = l_tile - tm_ * ntn; \
        const u16* ab_ = A + (size_t)rmap(tm_ * 128) * lda + l_kt * 64; \
        const u16* bb_ = bd.Bt + (size_t)(tn_ * 256) * bd.ldb + l_kt * 64; \
        _Pragma("unroll") for (int q_ = 0; q_ < 2; ++q_) { const int c_ = tid + 512 * q_; RA[q_] = *(const u32x4*)(ab_ + (size_t)(c_ >> 3) * lda + (c_ & 7) * 8); } \
        _Pragma("unroll") for (int q_ = 0; q_ < 4; ++q_) { const int c_ = tid + 512 * q_; RB[q_] = *(const u32x4*)(bb_ + (size_t)(c_ >> 3) * bd.ldb + (c_ & 7) * 8); } \
        { const int nk_ = l_kt + 1; const bool wrap_ = (nk_ == nkt); const bool more_ = (l_tile + G < ntiles); \
          l_kt = wrap_ ? 0 : nk_; l_tile = (wrap_ && more_) ? l_tile + G : l_tile; } } while (0)
#define V3_WRITE(RA, RB, GS) do { \
        ldsp As_ = lds + LDS_A3 + ((GS) & 1) * (128 * A_STR); ldsp Bs_ = lds + LDS_B3 + ((GS) & 1) * (256 * A_STR); \
        _Pragma("unroll") for (int q_ = 0; q_ < 2; ++q_) { const int c_ = tid + 512 * q_; *(LAS u32x4*)(As_ + (c_ >> 3) * A_STR + (c_ & 7) * 16) = RA[q_]; } \
        _Pragma("unroll") for (int q_ = 0; q_ < 4; ++q_) { const int c_ = tid + 512 * q_; *(LAS u32x4*)(Bs_ + (c_ >> 3) * A_STR + (c_ & 7) * 16) = RB[q_]; } } while (0)
    f32x4 acc[4][4];
#pragma unroll
    for (int i = 0; i < 4; ++i)
#pragma unroll
        for (int j = 0; j < 4; ++j) acc[i][j] = (f32x4){0.f, 0.f, 0.f, 0.f};
#define V3_STEP(RA, RB, GI) do { \
        V3_WRITE(RA, RB, (GI) + 1); \
        V3_LOAD(RA, RB); \
        { \
            const LAS unsigned char* ap_ = lds + LDS_A3 + ((GI) & 1) * (128 * A_STR) + (wr * 64 + (lane & 15)) * A_STR + g * 16; \
            const LAS unsigned char* bp_ = lds + LDS_B3 + ((GI) & 1) * (256 * A_STR) + (wc * 64 + (lane & 15)) * A_STR + g * 16; \
            _Pragma("unroll") for (int ks_ = 0; ks_ < 2; ++ks_) { \
                s16x8 a_[4], b_[4]; \
                _Pragma("unroll") for (int t_ = 0; t_ < 4; ++t_) { a_[t_] = *(const LAS s16x8*)(ap_ + t_ * 16 * A_STR + ks_ * 64); b_[t_] = *(const LAS s16x8*)(bp_ + t_ * 16 * A_STR + ks_ * 64); } \
                _Pragma("unroll") for (int mt_ = 0; mt_ < 4; ++mt_) _Pragma("unroll") for (int nt_ = 0; nt_ < 4; ++nt_) \
                    acc[mt_][nt_] = __builtin_amdgcn_mfma_f32_16x16x32_bf16(a_[mt_], b_[nt_], acc[mt_][nt_], 0, 0, 0); \
            } \
        } \
        if (++c_kt == nkt) { \
            if (c_tile < ntiles) { \
                const int tm_ = c_tile / ntn, tn_ = c_tile - tm_ * ntn; \
                const int mb_ = tm_ * 128 + wr * 64, gb_ = rmap(tm_ * 128) + wr * 64, cb_ = tn_ * 256 + wc * 64; \
                f32x4 cx0_, cx1_; epi.ctx(cb_ + (lane & 7) * 8, cx0_, cx1_);        \
                epi.pre(acc, gb_, cb_, lane); \
                ldsp tb_ = lds + LDS_T3 + wave * T3_SZ; \
                _Pragma("unroll") for (int mt_ = 0; mt_ < 4; ++mt_) { \
                    _Pragma("unroll") for (int nt_ = 0; nt_ < 4; ++nt_) _Pragma("unroll") for (int i_ = 0; i_ < 4; ++i_) \
                        *(LAS float*)(tb_ + (4 * g + i_) * T3_STR + (nt_ * 16 + (lane & 15)) * 4) = acc[mt_][nt_][i_]; \
                    _Pragma("unroll") for (int q_ = 0; q_ < 2; ++q_) { \
                        const int id_ = lane + 64 * q_, r_ = id_ >> 3, ch_ = id_ & 7; \
                        const f32x4 v0_ = *(const LAS f32x4*)(tb_ + r_ * T3_STR + ch_ * 32), v1_ = *(const LAS f32x4*)(tb_ + r_ * T3_STR + ch_ * 32 + 16); \
                        epi.store(mb_ + mt_ * 16 + r_, gb_ + mt_ * 16 + r_, cb_ + ch_ * 8, v0_, v1_, cx0_, cx1_); \
                    } \
                } \
            } \
            _Pragma("unroll") for (int i_ = 0; i_ < 4; ++i_) _Pragma("unroll") for (int j_ = 0; j_ < 4; ++j_) acc[i_][j_] = (f32x4){0.f, 0.f, 0.f, 0.f}; \
            c_kt = 0; c_tile += G; \
        } \
        __syncthreads(); } while (0)
    __syncthreads();
    V3_LOAD(ra0, rb0);
    V3_LOAD(ra1, rb1);
    V3_WRITE(ra0, rb0, 0);
    V3_LOAD(ra0, rb0);
    __syncthreads();
    for (int gi = 0; gi < S; gi += 2) {
        V3_STEP(ra1, rb1, gi);
        V3_STEP(ra0, rb0, gi + 1);
    }
#undef V3_LOAD
#undef V3_WRITE
#undef V3_STEP
}

template <class RowMap, class MakeB, class Epi>
DI void gemm_phase_f32(ldsp lds, const u16* A, int lda, int M, int N, int K, const RowMap& rmap, const MakeB& makeb, const Epi& epi) {
    const int lane = threadIdx.x & 63, wave = threadIdx.x >> 6, wr = wave >> 2, wc = wave & 3;
    const int ntn = (N + 255) >> 8, ntm = M >> 7, nkt = (K + 63) >> 6;
    for (int tile = blockIdx.x; tile < ntm * ntn; tile += gridDim.x) {
        const int tm = tile / ntn, tn = tile - tm * ntn;
        const int grow0 = rmap(tm * 128);
        ALoadDense al{A + (size_t)grow0 * lda, lda};
        auto bl = makeb(tn * 256);
        f32x4 acc[4][4];
#pragma unroll
        for (int i = 0; i < 4; ++i)
#pragma unroll
            for (int j = 0; j < 4; ++j) acc[i][j] = (f32x4){0.f, 0.f, 0.f, 0.f};
        gemm_kloop<true, A_STR>(lds, nkt, al, bl, acc, (const LAS unsigned char*)nullptr);
        epi(acc, tm * 128 + wr * 64, grow0 + wr * 64, tn * 256 + wc * 64, lane);
    }
}
struct MakeBDenseF { const float* W; int ldw, K, N; DI BLoadDenseU operator()(int col0) const { return BLoadDenseU{W + col0, ldw}; } };

#define EPI_LOOP  _Pragma("unroll") for (int mt = 0; mt < 4; ++mt) _Pragma("unroll") for (int nt = 0; nt < 4; ++nt) _Pragma("unroll") for (int i = 0; i < 4; ++i)
#define EPI_ROW(base) ((base) + mt * 16 + (lane >> 4) * 4 + i)
#define EPI_COL (cbase + nt * 16 + (lane & 15))

DI u32x4 pack8(const f32x4& a, const f32x4& b) { return (u32x4){pack2(a[0], a[1]), pack2(a[2], a[3]), pack2(b[0], b[1]), pack2(b[2], b[3])}; }
struct EpiInProj {
    u16* hp; const LAS f32x2* tab;
    DI void pre(f32x4 (&acc)[4][4], int gbase, int cbase, int lane) const {
        const bool rope_blk = (cbase < 640) || (cbase >= 768 && cbase < 1792);
        if (!rope_blk) return;
        const int f = lane & 15;
#pragma unroll
        for (int mt = 0; mt < 4; ++mt)
#pragma unroll
            for (int i = 0; i < 4; ++i) {
                const int row = gbase + mt * 16 + (lane >> 4) * 4 + i;
                const int n = row % NTOK;
                const bool lat = n >= CTXL;
                const int s = lat ? n - CTXL : 0;
                f32x2 cr = tab[(s >> 6) * 16 + f], cc = tab[(s & 63) * 16 + f];
                if (!lat) { cr = (f32x2){1.f, 0.f}; cc = (f32x2){1.f, 0.f}; }
                const float v0 = acc[mt][0][i], v1 = acc[mt][1][i], v2 = acc[mt][2][i], v3 = acc[mt][3][i];
                acc[mt][0][i] = v0 * cr[0] - v1 * cr[1]; acc[mt][1][i] = v1 * cr[0] + v0 * cr[1];
                acc[mt][2][i] = v2 * cc[0] - v3 * cc[1]; acc[mt][3][i] = v3 * cc[0] + v2 * cc[1];
            }
    }
    DI void ctx(int, f32x4& a, f32x4& b) const { a = (f32x4){0.f, 0.f, 0.f, 0.f}; b = a; }
    DI void store(int, int grow, int col, const f32x4& v0, const f32x4& v1, const f32x4&, const f32x4&) const { *(u32x4*)(hp + (size_t)grow * HPW + col) = pack8(v0, v1); }
};
struct EpiResid {
    float* z; const float* h; const float* modbase; int layer;
    DI void ctx(int, f32x4& a, f32x4& b) const { a = (f32x4){0.f, 0.f, 0.f, 0.f}; b = a; }
    DI void pre(f32x4 (&)[4][4], int, int, int) const {}
    DI void store(int, int grow, int col, const f32x4& v0, const f32x4& v1, const f32x4&, const f32x4&) const {
        const int mr = modrow_of(grow);
        const float* m2 = modbase + ((size_t)(layer * 9 + mr) * 6 + 2) * 1024 + col;
        const size_t o = (size_t)grow * D + col;
        const f32x4 h0 = *(const f32x4*)(h + o), h1 = *(const f32x4*)(h + o + 4);
        *(f32x4*)(z + o) = ALPHA * h0 + *(const f32x4*)m2 * v0;
        *(f32x4*)(z + o + 4) = ALPHA * h1 + *(const f32x4*)(m2 + 4) * v1;
    }
};
template <int ACT>
struct EpiBf16 {
    u16* out; int ld; int nvalid;
    DI void ctx(int, f32x4& a, f32x4& b) const { a = (f32x4){0.f, 0.f, 0.f, 0.f}; b = a; }
    DI void pre(f32x4 (&)[4][4], int, int, int) const {}
    DI void store(int, int grow, int col, f32x4 v0, f32x4 v1, const f32x4&, const f32x4&) const {
        if (col >= ld) return;
#pragma unroll
        for (int e = 0; e < 4; ++e) {
            if (ACT == 1) { v0[e] = tanhf(v0[e]); v1[e] = tanhf(v1[e]); }
            else if (ACT == 2) { v0[e] = sigmoidf_(v0[e]); v1[e] = sigmoidf_(v1[e]); }
        }
        if (col >= nvalid) { v0 = (f32x4){0.f, 0.f, 0.f, 0.f}; v1 = v0; }
        *(u32x4*)(out + (size_t)grow * ld + col) = pack8(v0, v1);
    }
};
struct EpiDecay {
    float* out; const float* dec0;
    DI void ctx(int col, f32x4& a, f32x4& b) const { a = *(const f32x4*)(dec0 + col); b = *(const f32x4*)(dec0 + col + 4); }
    DI void pre(f32x4 (&)[4][4], int, int, int) const {}
    DI void store(int, int grow, int col, const f32x4& v0, const f32x4& v1, const f32x4& c0, const f32x4& c1) const {
        f32x4 r0, r1;
#pragma unroll
        for (int e = 0; e < 4; ++e) {
            const float x0 = -(c0[e] + v0[e]), x1 = -(c1[e] + v1[e]);
            const float s0 = fmaxf(x0, 0.f) + __logf(1.f + __expf(-fabsf(x0))), s1 = fmaxf(x1, 0.f) + __logf(1.f + __expf(-fabsf(x1)));
            r0[e] = -__expf(-s0 - 0.5f); r1[e] = -__expf(-s1 - 0.5f);
        }
        *(f32x4*)(out + (size_t)grow * D + col) = r0; *(f32x4*)(out + (size_t)grow * D + col + 4) = r1;
    }
};
struct EpiSigBias {
    u16* out; const float* bias;
    DI void ctx(int col, f32x4& a, f32x4& b) const { a = *(const f32x4*)(bias + col); b = *(const f32x4*)(bias + col + 4); }
    DI void pre(f32x4 (&)[4][4], int, int, int) const {}
    DI void store(int, int grow, int col, f32x4 v0, f32x4 v1, const f32x4& c0, const f32x4& c1) const {
#pragma unroll
        for (int e = 0; e < 4; ++e) { v0[e] = sigmoidf_(c0[e] + v0[e]); v1[e] = sigmoidf_(c1[e] + v1[e]); }
        *(u32x4*)(out + (size_t)grow * D + col) = pack8(v0, v1);
    }
};
struct EpiSigScore {
    float* sc;
    DI void operator()(const f32x4 (&acc)[4][4], int mbase, int, int cbase, int lane) const {
        EPI_LOOP { sc[(size_t)EPI_ROW(mbase) * 256 + EPI_COL] = sigmoidf_(acc[mt][nt][i]); }
    }
};
struct EpiF32 {
    float* out; int ld;
    DI void operator()(const f32x4 (&acc)[4][4], int, int gbase, int cbase, int lane) const {
        EPI_LOOP { out[(size_t)EPI_ROW(gbase) * ld + EPI_COL] = acc[mt][nt][i]; }
    }
};


namespace pg8 {
constexpr int BM = 256, BK = 64, HALF = 128, HTB = HALF * BK * 2, STAGE_BYTES = 8 * HTB, NXCD = 8, WGM = 8;
DI int lds_byte(int r, int c) { const int st = (r >> 4) * 2 + (c >> 5), rr = r & 15, cc = c & 31, ob = rr * 64 + cc * 2; return st * 1024 + (ob ^ (((ob >> 9) & 1) << 5)); }
DI void stage_rc(int b, int& R, int& C) { const int st = b / 1024, sb = b % 1024, swz = sb ^ (((sb >> 9) & 1) << 5); R = (st >> 1) * 16 + swz / 64; C = (st & 1) * 32 + (swz % 64) / 2; }
DI int perm32(int rho) { const int n = rho >> 4, i = rho & 15; return 8 * (i >> 2) + 4 * n + (i & 3); }
struct Unit { int pm, pn, g, rows; };
struct Order {
    int nM, nN, per, total, G, c;
    DI void init(int M, int N, int NG, int G_, int c_) { nM = M / BM; nN = N / BM; per = nM * nN; total = per * NG; G = G_; c = c_; }
    DI bool next(int i, Unit& u) const {
        const int fr = total / G, rem = total - fr * G;
        const bool split = rem > 0 && 2 * rem <= G;
        long L; int half = 3;
        if (!split || i < fr) { L = (long)i * G + c; if (L >= total) return false; }
        else { if (i > fr || c >= 2 * rem) return false; L = (long)fr * G + (c >> 1); half = 1 + (c & 1); }
        u.g = (int)(L / per); int wgid = (int)(L - (long)u.g * per);
        { const int q = per / NXCD, r = per % NXCD, xcd = wgid % NXCD, off = wgid / NXCD; wgid = (xcd < r ? xcd * (q + 1) : r * (q + 1) + (xcd - r) * q) + off; }
        const int nig = WGM * nN, gid = wgid / nig, fm = gid * WGM, gsz = (nM - fm) < WGM ? (nM - fm) : WGM;
        u.pm = fm + ((wgid % nig) % gsz); u.pn = (wgid % nig) / gsz; u.rows = half; return true;
    }
};
template <class Epi, class Addr>
DI void gemm_phase(ldsp lds, int K, const Order& S, const Addr& AD, const Epi& E) {
    const int tid = threadIdx.x, wid = __builtin_amdgcn_readfirstlane(tid >> 6), lane = tid & 63, wr = wid >> 2, wc = wid & 3, fr = lane & 15, fq = lane >> 4;
    const int nt = K / BK;
    unsigned voffA[2], voffB[2];
#pragma unroll
    for (int i = 0; i < 2; ++i) { int R, C; stage_rc(tid * 16 + i * 8192, R, C); const int Rb = Epi::PERM ? ((R & ~31) + perm32(R & 31)) : R;
        voffA[i] = (unsigned)(R * K + C) * 2u; voffB[i] = (unsigned)(Rb * K + C) * 2u; }
    const size_t kstep = (size_t)(BK * 2);
    const size_t hstep = (size_t)HALF * K * 2;
    const unsigned ldsw = (unsigned)wid * 1024u;
    const int aoff = lds_byte(wr * 64 + fr, fq * 8), boff = lds_byte(wc * 32 + fr, fq * 8);
#define PG8_SA(b, h) (((b) * 2 + (h)) * HTB)
#define PG8_SB(b, h) ((4 + (b) * 2 + (h)) * HTB)
#define PG8_STAGE(bufoff, gbase, voff) do { _Pragma("unroll") for (int _i = 0; _i < 2; ++_i) \
        __builtin_amdgcn_global_load_lds((const unsigned*)((const char*)(gbase) + (voff)[_i]), (LAS unsigned*)(lds + (bufoff) + ldsw + _i * 8192), 16, 0, 0); } while (0)
#define PG8_LDA(dst, b, h) do { _Pragma("unroll") for (int m = 0; m < 4; ++m) _Pragma("unroll") for (int k = 0; k < 2; ++k) dst[m][k] = *(const LAS s16x8*)(lds + PG8_SA(b, h) + aoff + m * 2048 + k * 1024); } while (0)
#define PG8_LDB(dst, b, h) do { _Pragma("unroll") for (int n = 0; n < 2; ++n) _Pragma("unroll") for (int k = 0; k < 2; ++k) dst[n][k] = *(const LAS s16x8*)(lds + PG8_SB(b, h) + boff + n * 2048 + k * 1024); } while (0)
#define PG8_MMA(ai, bj, At, Bt) do { __builtin_amdgcn_s_setprio(1); _Pragma("unroll") for (int m = 0; m < 4; ++m) _Pragma("unroll") for (int n = 0; n < 2; ++n) _Pragma("unroll") for (int k = 0; k < 2; ++k) \
        acc[ai][bj][m][n] = __builtin_amdgcn_mfma_f32_16x16x32_bf16(Bt[n][k], At[m][k], acc[ai][bj][m][n], 0, 0, 0); __builtin_amdgcn_s_setprio(0); } while (0)
#define PG8_WAIT_V(n) asm volatile("s_waitcnt vmcnt(" #n ")" ::: "memory")
#define PG8_WAIT_L(n) asm volatile("s_waitcnt lgkmcnt(" #n ")" ::: "memory")
#define PG8_BAR __builtin_amdgcn_s_barrier()
#define PG8_SCHED __builtin_amdgcn_sched_barrier(0)
    Unit cur, nxt; int ui = 0;
    if (!S.next(0, cur)) return;
    f32x4 acc[2][2][4][2];
#pragma unroll
    for (int a = 0; a < 2; ++a)
#pragma unroll
        for (int b = 0; b < 2; ++b)
#pragma unroll
            for (int m = 0; m < 4; ++m)
#pragma unroll
                for (int n = 0; n < 2; ++n) acc[a][b][m][n] = (f32x4){0.f, 0.f, 0.f, 0.f};
    s16x8 At[4][2], B0[2][2], B1[2][2];
    const char* cA = AD.a(cur); const char* cB = AD.b(cur);
    PG8_STAGE(PG8_SB(0, 0), cB, voffB); PG8_STAGE(PG8_SA(0, 0), cA, voffA); PG8_STAGE(PG8_SB(0, 1), cB + hstep, voffB); PG8_STAGE(PG8_SA(0, 1), cA + hstep, voffA);
    if (wr == 1) PG8_BAR;
    PG8_WAIT_V(4); PG8_BAR;
    PG8_STAGE(PG8_SB(1, 0), cB + kstep, voffB); PG8_STAGE(PG8_SA(1, 0), cA + kstep, voffA); PG8_STAGE(PG8_SB(1, 1), cB + hstep + kstep, voffB);
    PG8_WAIT_V(6); PG8_BAR;
    for (;;) {
        const bool has_next = S.next(ui + 1, nxt);
        const char* nA = has_next ? AD.a(nxt) : cA; const char* nB = has_next ? AD.b(nxt) : cB;
        const bool lo_ = (cur.rows & 1) != 0, hi_ = (cur.rows & 2) != 0;
        for (int t = 0; t < nt; t += 2) {
            const bool last = (t == nt - 2);
            const char* a1 = cA + (size_t)(t + 1) * kstep;
            const char* a2 = last ? nA : cA + (size_t)(t + 2) * kstep; const char* b2 = last ? nB : cB + (size_t)(t + 2) * kstep;
            const char* a3 = a2 + kstep; const char* b3 = b2 + kstep;
            PG8_LDB(B0, 0, 0); PG8_SCHED; if (lo_) PG8_LDA(At, 0, 0); PG8_STAGE(PG8_SA(1, 1), a1 + hstep, voffA);
            PG8_WAIT_L(8); PG8_BAR; PG8_WAIT_L(0); if (lo_) PG8_MMA(0, 0, At, B0); PG8_BAR; PG8_SCHED;
            PG8_LDB(B1, 0, 1); PG8_STAGE(PG8_SB(0, 0), b2, voffB);
            PG8_BAR; PG8_WAIT_L(0); if (lo_) PG8_MMA(0, 1, At, B1); PG8_BAR;
            if (hi_) PG8_LDA(At, 0, 1); PG8_STAGE(PG8_SA(0, 0), a2, voffA);
            PG8_BAR; PG8_WAIT_L(0); if (hi_) PG8_MMA(1, 0, At, B0); PG8_BAR; PG8_SCHED;
            PG8_STAGE(PG8_SB(0, 1), b2 + hstep, voffB);
            PG8_WAIT_V(6); PG8_BAR; if (hi_) PG8_MMA(1, 1, At, B1); PG8_BAR;
            PG8_LDB(B0, 1, 0); PG8_SCHED; if (lo_) PG8_LDA(At, 1, 0); PG8_STAGE(PG8_SA(0, 1), a2 + hstep, voffA);
            PG8_WAIT_L(8); PG8_BAR; PG8_WAIT_L(0); if (lo_) PG8_MMA(0, 0, At, B0); PG8_BAR; PG8_SCHED;
            PG8_LDB(B1, 1, 1); PG8_STAGE(PG8_SB(1, 0), b3, voffB);
            PG8_BAR; PG8_WAIT_L(0); if (lo_) PG8_MMA(0, 1, At, B1); PG8_BAR;
            if (hi_) PG8_LDA(At, 1, 1); PG8_STAGE(PG8_SA(1, 0), a3, voffA);
            PG8_BAR; PG8_WAIT_L(0); if (hi_) PG8_MMA(1, 0, At, B0); PG8_BAR; PG8_SCHED;
            PG8_STAGE(PG8_SB(1, 1), b3 + hstep, voffB);
            PG8_WAIT_V(6); PG8_BAR; if (hi_) PG8_MMA(1, 1, At, B1); PG8_BAR;
        }
        E(acc, cur, wr, wc, fr, fq);
        if (!has_next) break;
#pragma unroll
        for (int a = 0; a < 2; ++a)
#pragma unroll
            for (int b = 0; b < 2; ++b)
#pragma unroll
                for (int m = 0; m < 4; ++m)
#pragma unroll
                    for (int n = 0; n < 2; ++n) acc[a][b][m][n] = (f32x4){0.f, 0.f, 0.f, 0.f};
        cur = nxt; cA = nA; cB = nB; ++ui;
    }
    PG8_WAIT_V(0);
    if (wr == 0) PG8_BAR;
    PG8_BAR;
#undef PG8_SA
#undef PG8_SB
#undef PG8_STAGE
#undef PG8_LDA
#undef PG8_LDB
#undef PG8_MMA
#undef PG8_WAIT_V
#undef PG8_WAIT_L
#undef PG8_BAR
#undef PG8_SCHED
}

template <class Epi, class Sched, class Addr>
DI void gemm_phase_gather(ldsp lds, int K, const Sched& S, const Addr& AD, const Epi& E) {
    int tid_ = threadIdx.x; asm volatile("" : "+v"(tid_));
    const int tid = tid_, wid = __builtin_amdgcn_readfirstlane(tid >> 6), lane = tid & 63, wr = wid >> 2, wc = wid & 3, fr = lane & 15, fq = lane >> 4;
    const int nt = K / BK;
    unsigned voffB[2]; int stR[2], stC[2];
#pragma unroll
    for (int i = 0; i < 2; ++i) { int R, C; stage_rc(tid * 16 + i * 8192, R, C); const int Rb = Epi::PERM ? ((R & ~31) + perm32(R & 31)) : R;
        stR[i] = R; stC[i] = C; voffB[i] = (unsigned)(Rb * BK + C) * 2u;          }
    unsigned cv0[2], cv1[2], nv0[2], nv1[2];
#define PG8_GOFF(v0, v1, u) do { _Pragma("unroll") for (int _i = 0; _i < 2; ++_i) { \
        v0[_i] = ((unsigned)AD.arow(u, stR[_i]) * (unsigned)K + (unsigned)stC[_i]) * 2u; v1[_i] = ((unsigned)AD.arow(u, HALF + stR[_i]) * (unsigned)K + (unsigned)stC[_i]) * 2u; } } while (0)
    const size_t kstep = (size_t)(BK * 2);
    const size_t hstep = (size_t)HALF * K * 2;
    const size_t kstepB = (size_t)BM * BK * 2, hstepB = (size_t)HALF * BK * 2;
    const unsigned ldsw = (unsigned)wid * 1024u;
    const int aoff = lds_byte(wr * 64 + fr, fq * 8), boff = lds_byte(wc * 32 + fr, fq * 8);
#define PG8_SA(b, h) (((b) * 2 + (h)) * HTB)
#define PG8_SB(b, h) ((4 + (b) * 2 + (h)) * HTB)
#define PG8_STAGE(bufoff, gbase, voff) do { _Pragma("unroll") for (int _i = 0; _i < 2; ++_i) \
        __builtin_amdgcn_global_load_lds((const unsigned*)((const char*)(gbase) + (voff)[_i]), (LAS unsigned*)(lds + (bufoff) + ldsw + _i * 8192), 16, 0, 0); } while (0)
#define PG8_LDA(dst, b, h) do { _Pragma("unroll") for (int m = 0; m < 4; ++m) _Pragma("unroll") for (int k = 0; k < 2; ++k) dst[m][k] = *(const LAS s16x8*)(lds + PG8_SA(b, h) + aoff + m * 2048 + k * 1024); } while (0)
#define PG8_LDB(dst, b, h) do { _Pragma("unroll") for (int n = 0; n < 2; ++n) _Pragma("unroll") for (int k = 0; k < 2; ++k) dst[n][k] = *(const LAS s16x8*)(lds + PG8_SB(b, h) + boff + n * 2048 + k * 1024); } while (0)
#define PG8_MMA(ai, bj, At, Bt) do { __builtin_amdgcn_s_setprio(1); _Pragma("unroll") for (int m = 0; m < 4; ++m) _Pragma("unroll") for (int n = 0; n < 2; ++n) _Pragma("unroll") for (int k = 0; k < 2; ++k) \
        acc[ai][bj][m][n] = __builtin_amdgcn_mfma_f32_16x16x32_bf16(Bt[n][k], At[m][k], acc[ai][bj][m][n], 0, 0, 0); __builtin_amdgcn_s_setprio(0); } while (0)
#define PG8_WAIT_V(n) asm volatile("s_waitcnt vmcnt(" #n ")" ::: "memory")
#define PG8_WAIT_L(n) asm volatile("s_waitcnt lgkmcnt(" #n ")" ::: "memory")
#define PG8_BAR __builtin_amdgcn_s_barrier()
#define PG8_SCHED __builtin_amdgcn_sched_barrier(0)
    Unit cur, nxt; int ui = 0;
    if (!S.next(0, cur)) return;
    f32x4 acc[2][2][4][2];
#pragma unroll
    for (int a = 0; a < 2; ++a)
#pragma unroll
        for (int b = 0; b < 2; ++b)
#pragma unroll
            for (int m = 0; m < 4; ++m)
#pragma unroll
                for (int n = 0; n < 2; ++n) acc[a][b][m][n] = (f32x4){0.f, 0.f, 0.f, 0.f};
    s16x8 At[4][2], B0[2][2], B1[2][2];
    const char* cA = AD.a0(); const char* cB = AD.b(cur);
    PG8_GOFF(cv0, cv1, cur);
    PG8_STAGE(PG8_SB(0, 0), cB, voffB); PG8_STAGE(PG8_SA(0, 0), cA, cv0); PG8_STAGE(PG8_SB(0, 1), cB + hstepB, voffB); PG8_STAGE(PG8_SA(0, 1), cA, cv1);
    if (wr == 1) PG8_BAR;
    PG8_WAIT_V(4); PG8_BAR;
    PG8_STAGE(PG8_SB(1, 0), cB + kstepB, voffB); PG8_STAGE(PG8_SA(1, 0), cA + kstep, cv0); PG8_STAGE(PG8_SB(1, 1), cB + hstepB + kstepB, voffB);
    PG8_WAIT_V(6); PG8_BAR;
    for (;;) {
        const bool has_next = S.next(ui + 1, nxt);
        const char* nB = has_next ? AD.b(nxt) : cB;
        if (has_next) PG8_GOFF(nv0, nv1, nxt); else { nv0[0] = cv0[0]; nv0[1] = cv0[1]; nv1[0] = cv1[0]; nv1[1] = cv1[1]; }
        const bool lo_ = (cur.rows & 1) != 0, hi_ = (cur.rows & 2) != 0;
        for (int t = 0; t < nt; t += 2) {
            const bool last = (t == nt - 2);
            const char* a1 = cA + (size_t)(t + 1) * kstep;
            const char* a2 = last ? cA : cA + (size_t)(t + 2) * kstep; const char* b2 = last ? nB : cB + (size_t)(t + 2) * kstepB;
            unsigned w0[2], w1[2]; w0[0] = last ? nv0[0] : cv0[0]; w0[1] = last ? nv0[1] : cv0[1]; w1[0] = last ? nv1[0] : cv1[0]; w1[1] = last ? nv1[1] : cv1[1];
            const char* a3 = a2 + kstep; const char* b3 = b2 + kstepB;
            PG8_LDB(B0, 0, 0); PG8_SCHED; if (lo_) PG8_LDA(At, 0, 0); PG8_STAGE(PG8_SA(1, 1), a1, cv1);
            PG8_WAIT_L(8); PG8_BAR; PG8_WAIT_L(0); if (lo_) PG8_MMA(0, 0, At, B0); PG8_BAR; PG8_SCHED;
            PG8_LDB(B1, 0, 1); PG8_STAGE(PG8_SB(0, 0), b2, voffB);
            PG8_BAR; PG8_WAIT_L(0); if (lo_) PG8_MMA(0, 1, At, B1); PG8_BAR;
            if (hi_) PG8_LDA(At, 0, 1); PG8_STAGE(PG8_SA(0, 0), a2, w0);
            PG8_BAR; PG8_WAIT_L(0); if (hi_) PG8_MMA(1, 0, At, B0); PG8_BAR; PG8_SCHED;
            PG8_STAGE(PG8_SB(0, 1), b2 + hstepB, voffB);
            PG8_WAIT_V(6); PG8_BAR; if (hi_) PG8_MMA(1, 1, At, B1); PG8_BAR;
            PG8_LDB(B0, 1, 0); PG8_SCHED; if (lo_) PG8_LDA(At, 1, 0); PG8_STAGE(PG8_SA(0, 1), a2, w1);
            PG8_WAIT_L(8); PG8_BAR; PG8_WAIT_L(0); if (lo_) PG8_MMA(0, 0, At, B0); PG8_BAR; PG8_SCHED;
            PG8_LDB(B1, 1, 1); PG8_STAGE(PG8_SB(1, 0), b3, voffB);
            PG8_BAR; PG8_WAIT_L(0); if (lo_) PG8_MMA(0, 1, At, B1); PG8_BAR;
            if (hi_) PG8_LDA(At, 1, 1); PG8_STAGE(PG8_SA(1, 0), a3, w0);
            PG8_BAR; PG8_WAIT_L(0); if (hi_) PG8_MMA(1, 0, At, B0); PG8_BAR; PG8_SCHED;
            PG8_STAGE(PG8_SB(1, 1), b3 + hstepB, voffB);
            PG8_WAIT_V(6); PG8_BAR; if (hi_) PG8_MMA(1, 1, At, B1); PG8_BAR;
        }
        E(acc, cur, wr, wc, fr, fq);
        if (!has_next) break;
#pragma unroll
        for (int a = 0; a < 2; ++a)
#pragma unroll
            for (int b = 0; b < 2; ++b)
#pragma unroll
                for (int m = 0; m < 4; ++m)
#pragma unroll
                    for (int n = 0; n < 2; ++n) acc[a][b][m][n] = (f32x4){0.f, 0.f, 0.f, 0.f};
        cur = nxt; cB = nB; ++ui; cv0[0] = nv0[0]; cv0[1] = nv0[1]; cv1[0] = nv1[0]; cv1[1] = nv1[1];
    }
    PG8_WAIT_V(0);
    if (wr == 0) PG8_BAR;
    PG8_BAR;
#undef PG8_GOFF
#undef PG8_SA
#undef PG8_SB
#undef PG8_STAGE
#undef PG8_LDA
#undef PG8_LDB
#undef PG8_MMA
#undef PG8_WAIT_V
#undef PG8_WAIT_L
#undef PG8_BAR
#undef PG8_SCHED
}


template <class Epi, class Sched, class Addr>
DI void gemm_phase_s(ldsp lds, int K, const Sched& S, const Addr& AD, const Epi& E) {
    int tid_ = threadIdx.x; asm volatile("" : "+v"(tid_));
    const int tid = tid_, wid = __builtin_amdgcn_readfirstlane(tid >> 6), lane = tid & 63, wr = wid >> 2, wc = wid & 3, fr = lane & 15, fq = lane >> 4;
    const int nt = K / BK;
    unsigned voffA[2], voffB[2];
#pragma unroll
    for (int i = 0; i < 2; ++i) { int R, C; stage_rc(tid * 16 + i * 8192, R, C); const int Rb = Epi::PERM ? ((R & ~31) + perm32(R & 31)) : R;
        voffA[i] = (unsigned)(R * K + C) * 2u; voffB[i] = (unsigned)(Rb * K + C) * 2u; }
    const size_t kstep = (size_t)(BK * 2);
    const size_t hstep = (size_t)HALF * K * 2;
    const unsigned ldsw = (unsigned)wid * 1024u;
    const int aoff = lds_byte(wr * 64 + fr, fq * 8), boff = lds_byte(wc * 32 + fr, fq * 8);
#define PG8_SA(b, h) (((b) * 2 + (h)) * HTB)
#define PG8_SB(b, h) ((4 + (b) * 2 + (h)) * HTB)
#define PG8_STAGE(bufoff, gbase, voff) do { _Pragma("unroll") for (int _i = 0; _i < 2; ++_i) \
        __builtin_amdgcn_global_load_lds((const unsigned*)((const char*)(gbase) + (voff)[_i]), (LAS unsigned*)(lds + (bufoff) + ldsw + _i * 8192), 16, 0, 0); } while (0)
#define PG8_LDA(dst, b, h) do { _Pragma("unroll") for (int m = 0; m < 4; ++m) _Pragma("unroll") for (int k = 0; k < 2; ++k) dst[m][k] = *(const LAS s16x8*)(lds + PG8_SA(b, h) + aoff + m * 2048 + k * 1024); } while (0)
#define PG8_LDB(dst, b, h) do { _Pragma("unroll") for (int n = 0; n < 2; ++n) _Pragma("unroll") for (int k = 0; k < 2; ++k) dst[n][k] = *(const LAS s16x8*)(lds + PG8_SB(b, h) + boff + n * 2048 + k * 1024); } while (0)
#define PG8_MMA(ai, bj, At, Bt) do { __builtin_amdgcn_s_setprio(1); _Pragma("unroll") for (int m = 0; m < 4; ++m) _Pragma("unroll") for (int n = 0; n < 2; ++n) _Pragma("unroll") for (int k = 0; k < 2; ++k) \
        acc[ai][bj][m][n] = __builtin_amdgcn_mfma_f32_16x16x32_bf16(Bt[n][k], At[m][k], acc[ai][bj][m][n], 0, 0, 0); __builtin_amdgcn_s_setprio(0); } while (0)
#define PG8_WAIT_V(n) asm volatile("s_waitcnt vmcnt(" #n ")" ::: "memory")
#define PG8_WAIT_L(n) asm volatile("s_waitcnt lgkmcnt(" #n ")" ::: "memory")
#define PG8_BAR __builtin_amdgcn_s_barrier()
#define PG8_SCHED __builtin_amdgcn_sched_barrier(0)
    Unit cur, nxt; int ui = 0;
    if (!S.next(0, cur)) return;
    f32x4 acc[2][2][4][2];
#pragma unroll
    for (int a = 0; a < 2; ++a)
#pragma unroll
        for (int b = 0; b < 2; ++b)
#pragma unroll
            for (int m = 0; m < 4; ++m)
#pragma unroll
                for (int n = 0; n < 2; ++n) acc[a][b][m][n] = (f32x4){0.f, 0.f, 0.f, 0.f};
    s16x8 At[4][2], B0[2][2], B1[2][2];
    const char* cA = AD.a(cur); const char* cB = AD.b(cur);
    PG8_STAGE(PG8_SB(0, 0), cB, voffB); PG8_STAGE(PG8_SA(0, 0), cA, voffA); PG8_STAGE(PG8_SB(0, 1), cB + hstep, voffB); PG8_STAGE(PG8_SA(0, 1), cA + hstep, voffA);
    if (wr == 1) PG8_BAR;
    PG8_WAIT_V(4); PG8_BAR;
    PG8_STAGE(PG8_SB(1, 0), cB + kstep, voffB); PG8_STAGE(PG8_SA(1, 0), cA + kstep, voffA); PG8_STAGE(PG8_SB(1, 1), cB + hstep + kstep, voffB);
    PG8_WAIT_V(6); PG8_BAR;
    for (;;) {
        const bool has_next = S.next(ui + 1, nxt);
        const char* nA = has_next ? AD.a(nxt) : cA; const char* nB = has_next ? AD.b(nxt) : cB;
#pragma unroll 1
        for (int t = 0; t < nt; t += 2) {
            const bool last = (t == nt - 2);
            const char* a1 = cA + (size_t)(t + 1) * kstep;
            const char* a2 = last ? nA : cA + (size_t)(t + 2) * kstep; const char* b2 = last ? nB : cB + (size_t)(t + 2) * kstep;
            const char* a3 = a2 + kstep; const char* b3 = b2 + kstep;
            PG8_LDB(B0, 0, 0); PG8_SCHED; PG8_LDA(At, 0, 0); PG8_STAGE(PG8_SA(1, 1), a1 + hstep, voffA);
            PG8_WAIT_L(8); PG8_BAR; PG8_WAIT_L(0); PG8_MMA(0, 0, At, B0); PG8_BAR; PG8_SCHED;
            PG8_LDB(B1, 0, 1); PG8_STAGE(PG8_SB(0, 0), b2, voffB);
            PG8_BAR; PG8_WAIT_L(0); PG8_MMA(0, 1, At, B1); PG8_BAR;
            PG8_LDA(At, 0, 1); PG8_STAGE(PG8_SA(0, 0), a2, voffA);
            PG8_BAR; PG8_WAIT_L(0); PG8_MMA(1, 0, At, B0); PG8_BAR; PG8_SCHED;
            PG8_STAGE(PG8_SB(0, 1), b2 + hstep, voffB);
            PG8_WAIT_V(6); PG8_BAR; PG8_MMA(1, 1, At, B1); PG8_BAR;
            PG8_LDB(B0, 1, 0); PG8_SCHED; PG8_LDA(At, 1, 0); PG8_STAGE(PG8_SA(0, 1), a2 + hstep, voffA);
            PG8_WAIT_L(8); PG8_BAR; PG8_WAIT_L(0); PG8_MMA(0, 0, At, B0); PG8_BAR; PG8_SCHED;
            PG8_LDB(B1, 1, 1); PG8_STAGE(PG8_SB(1, 0), b3, voffB);
            PG8_BAR; PG8_WAIT_L(0); PG8_MMA(0, 1, At, B1); PG8_BAR;
            PG8_LDA(At, 1, 1); PG8_STAGE(PG8_SA(1, 0), a3, voffA);
            PG8_BAR; PG8_WAIT_L(0); PG8_MMA(1, 0, At, B0); PG8_BAR; PG8_SCHED;
            PG8_STAGE(PG8_SB(1, 1), b3 + hstep, voffB);
            PG8_WAIT_V(6); PG8_BAR; PG8_MMA(1, 1, At, B1); PG8_BAR;
        }
        E(acc, cur, wr, wc, fr, fq);
        if (!has_next) break;
#pragma unroll
        for (int a = 0; a < 2; ++a)
#pragma unroll
            for (int b = 0; b < 2; ++b)
#pragma unroll
                for (int m = 0; m < 4; ++m)
#pragma unroll
                    for (int n = 0; n < 2; ++n) acc[a][b][m][n] = (f32x4){0.f, 0.f, 0.f, 0.f};
        cur = nxt; cA = nA; cB = nB; ++ui;
    }
    PG8_WAIT_V(0);
    if (wr == 0) PG8_BAR;
    PG8_BAR;
#undef PG8_SA
#undef PG8_SB
#undef PG8_STAGE
#undef PG8_LDA
#undef PG8_LDB
#undef PG8_MMA
#undef PG8_WAIT_V
#undef PG8_WAIT_L
#undef PG8_BAR
#undef PG8_SCHED
}


template <class Epi, class Sched, class Addr>
DI void gemm_phase_st(ldsp lds, int K, const Sched& S, const Addr& AD, const Epi& E) {
    int tid_ = threadIdx.x; asm volatile("" : "+v"(tid_));
    const int tid = tid_, wid = __builtin_amdgcn_readfirstlane(tid >> 6), lane = tid & 63, wr = wid >> 2, wc = wid & 3, fr = lane & 15, fq = lane >> 4;
    const int nt = K / BK;
    unsigned voffA[2], voffB[2];
#pragma unroll
    for (int i = 0; i < 2; ++i) { int R, C; stage_rc(tid * 16 + i * 8192, R, C); const int Rb = Epi::PERM ? ((R & ~31) + perm32(R & 31)) : R;
        voffA[i] = (unsigned)(R * K + C) * 2u; voffB[i] = (unsigned)(Rb * BK + C) * 2u;          }
    const size_t kstep = (size_t)(BK * 2);
    const size_t hstep = (size_t)HALF * K * 2;
    const size_t kstepB = (size_t)BM * BK * 2, hstepB = (size_t)HALF * BK * 2;
    const unsigned ldsw = (unsigned)wid * 1024u;
    const int aoff = lds_byte(wr * 64 + fr, fq * 8), boff = lds_byte(wc * 32 + fr, fq * 8);
#define PG8_SA(b, h) (((b) * 2 + (h)) * HTB)
#define PG8_SB(b, h) ((4 + (b) * 2 + (h)) * HTB)
#define PG8_STAGE(bufoff, gbase, voff) do { _Pragma("unroll") for (int _i = 0; _i < 2; ++_i) \
        __builtin_amdgcn_global_load_lds((const unsigned*)((const char*)(gbase) + (voff)[_i]), (LAS unsigned*)(lds + (bufoff) + ldsw + _i * 8192), 16, 0, 0); } while (0)
#define PG8_LDA(dst, b, h) do { _Pragma("unroll") for (int m = 0; m < 4; ++m) _Pragma("unroll") for (int k = 0; k < 2; ++k) dst[m][k] = *(const LAS s16x8*)(lds + PG8_SA(b, h) + aoff + m * 2048 + k * 1024); } while (0)
#define PG8_LDB(dst, b, h) do { _Pragma("unroll") for (int n = 0; n < 2; ++n) _Pragma("unroll") for (int k = 0; k < 2; ++k) dst[n][k] = *(const LAS s16x8*)(lds + PG8_SB(b, h) + boff + n * 2048 + k * 1024); } while (0)
#define PG8_MMA(ai, bj, At, Bt) do { __builtin_amdgcn_s_setprio(1); _Pragma("unroll") for (int m = 0; m < 4; ++m) _Pragma("unroll") for (int n = 0; n < 2; ++n) _Pragma("unroll") for (int k = 0; k < 2; ++k) \
        acc[ai][bj][m][n] = __builtin_amdgcn_mfma_f32_16x16x32_bf16(Bt[n][k], At[m][k], acc[ai][bj][m][n], 0, 0, 0); __builtin_amdgcn_s_setprio(0); } while (0)
#define PG8_WAIT_V(n) asm volatile("s_waitcnt vmcnt(" #n ")" ::: "memory")
#define PG8_WAIT_L(n) asm volatile("s_waitcnt lgkmcnt(" #n ")" ::: "memory")
#define PG8_BAR __builtin_amdgcn_s_barrier()
#define PG8_SCHED __builtin_amdgcn_sched_barrier(0)
    Unit cur, nxt; int ui = 0;
    if (!S.next(0, cur)) return;
    f32x4 acc[2][2][4][2];
#pragma unroll
    for (int a = 0; a < 2; ++a)
#pragma unroll
        for (int b = 0; b < 2; ++b)
#pragma unroll
            for (int m = 0; m < 4; ++m)
#pragma unroll
                for (int n = 0; n < 2; ++n) acc[a][b][m][n] = (f32x4){0.f, 0.f, 0.f, 0.f};
    s16x8 At[4][2], B0[2][2], B1[2][2];
    { const typename Epi::Pre q0 = E.prefetch(cur); E.commit(q0, 0); }
    const char* cA = AD.a(cur); const char* cB = AD.b(cur);
    PG8_STAGE(PG8_SB(0, 0), cB, voffB); PG8_STAGE(PG8_SA(0, 0), cA, voffA); PG8_STAGE(PG8_SB(0, 1), cB + hstepB, voffB); PG8_STAGE(PG8_SA(0, 1), cA + hstep, voffA);
    if (wr == 1) PG8_BAR;
    PG8_WAIT_V(4); PG8_BAR;
    PG8_STAGE(PG8_SB(1, 0), cB + kstepB, voffB); PG8_STAGE(PG8_SA(1, 0), cA + kstep, voffA); PG8_STAGE(PG8_SB(1, 1), cB + hstepB + kstepB, voffB);
    PG8_WAIT_V(6); PG8_BAR;
    for (;;) {
        const bool has_next = S.next(ui + 1, nxt);
        const char* nA = has_next ? AD.a(nxt) : cA; const char* nB = has_next ? AD.b(nxt) : cB;
        const bool lo_ = (cur.rows & 1) != 0, hi_ = (cur.rows & 2) != 0;
#pragma unroll 1
        for (int t = 0; t < nt; t += 2) {
            const bool last = (t == nt - 2);
            const char* a1 = cA + (size_t)(t + 1) * kstep;
            const char* a2 = last ? nA : cA + (size_t)(t + 2) * kstep; const char* b2 = last ? nB : cB + (size_t)(t + 2) * kstepB;
            const char* a3 = a2 + kstep; const char* b3 = b2 + kstepB;
            PG8_LDB(B0, 0, 0); PG8_SCHED; if (lo_) PG8_LDA(At, 0, 0); PG8_STAGE(PG8_SA(1, 1), a1 + hstep, voffA);
            PG8_WAIT_L(8); PG8_BAR; PG8_WAIT_L(0); if (lo_) PG8_MMA(0, 0, At, B0); PG8_BAR; PG8_SCHED;
            PG8_LDB(B1, 0, 1); PG8_STAGE(PG8_SB(0, 0), b2, voffB);
            PG8_BAR; PG8_WAIT_L(0); if (lo_) PG8_MMA(0, 1, At, B1); PG8_BAR;
            if (hi_) PG8_LDA(At, 0, 1); PG8_STAGE(PG8_SA(0, 0), a2, voffA);
            PG8_BAR; PG8_WAIT_L(0); if (hi_) PG8_MMA(1, 0, At, B0); PG8_BAR; PG8_SCHED;
            PG8_STAGE(PG8_SB(0, 1), b2 + hstepB, voffB);
            PG8_WAIT_V(6); PG8_BAR; if (hi_) PG8_MMA(1, 1, At, B1); PG8_BAR;
            PG8_LDB(B0, 1, 0); PG8_SCHED; if (lo_) PG8_LDA(At, 1, 0); PG8_STAGE(PG8_SA(0, 1), a2 + hstep, voffA);
            PG8_WAIT_L(8); PG8_BAR; PG8_WAIT_L(0); if (lo_) PG8_MMA(0, 0, At, B0); PG8_BAR; PG8_SCHED;
            PG8_LDB(B1, 1, 1); PG8_STAGE(PG8_SB(1, 0), b3, voffB);
            PG8_BAR; PG8_WAIT_L(0); if (lo_) PG8_MMA(0, 1, At, B1); PG8_BAR;
            if (hi_) PG8_LDA(At, 1, 1); PG8_STAGE(PG8_SA(1, 0), a3, voffA);
            PG8_BAR; PG8_WAIT_L(0); if (hi_) PG8_MMA(1, 0, At, B0); PG8_BAR; PG8_SCHED;
            PG8_STAGE(PG8_SB(1, 1), b3 + hstepB, voffB);
            PG8_WAIT_V(6); PG8_BAR; if (hi_) PG8_MMA(1, 1, At, B1); PG8_BAR;
        }
        const typename Epi::Pre qn = E.prefetch(has_next ? nxt : cur);
        E(acc, cur, wr, wc, fr, fq, ui & 1);
        E.commit(qn, (ui + 1) & 1);
        if (!has_next) break;
#pragma unroll
        for (int a = 0; a < 2; ++a)
#pragma unroll
            for (int b = 0; b < 2; ++b)
#pragma unroll
                for (int m = 0; m < 4; ++m)
#pragma unroll
                    for (int n = 0; n < 2; ++n) acc[a][b][m][n] = (f32x4){0.f, 0.f, 0.f, 0.f};
        cur = nxt; cA = nA; cB = nB; ++ui;
    }
    PG8_WAIT_V(0);
    if (wr == 0) PG8_BAR;
    PG8_BAR;
#undef PG8_SA
#undef PG8_SB
#undef PG8_STAGE
#undef PG8_LDA
#undef PG8_LDB
#undef PG8_MMA
#undef PG8_WAIT_V
#undef PG8_WAIT_L
#undef PG8_BAR
#undef PG8_SCHED
}


struct AddrOne {
    const u16* A; const u16* Bt; int K; bool lat;
    DI const char* a(const Unit& u) const { const int m0 = u.pm * BM; const int r0 = lat ? ((m0 >> 11) * NTOK + CTXL + (m0 & 2047)) : m0; return (const char*)(A + (size_t)r0 * K); }
    DI const char* b(const Unit& u) const { return (const char*)(Bt + (size_t)u.pn * BM * K); }
};
struct AddrThree {
    const u16* A; const u16* Bt;
    DI const char* a(const Unit& u) const { const int mi = u.g + (u.g > 0 ? 1 : 0); return (const char*)(A + ((size_t)mi * T + (size_t)u.pm * BM) * D); }
    DI const char* b(const Unit& u) const { return (const char*)(Bt + ((size_t)u.g * D + (size_t)u.pn * BM) * D); }
};
struct EpiBf16P {
    static constexpr bool PERM = true;
    u16* out; int ld; size_t gstride;
    DI void operator()(const f32x4 (&acc)[2][2][4][2], const Unit& u, int wr, int wc, int fr, int fq) const {
        u16* base = out + (size_t)u.g * gstride;
        const int row0 = u.pm * BM + wr * 64 + fr, col0 = u.pn * BM + wc * 32 + 8 * fq;
#pragma unroll
        for (int ai = 0; ai < 2; ++ai) {
            if (!((u.rows >> ai) & 1)) continue;
#pragma unroll
            for (int m = 0; m < 4; ++m) { u16* rowp = base + (size_t)(row0 + ai * HALF + m * 16) * ld + col0;
#pragma unroll
                for (int bj = 0; bj < 2; ++bj) *(u32x4*)(rowp + bj * HALF) = pack8(acc[ai][bj][m][0], acc[ai][bj][m][1]); }
        }
    }
};
struct EpiInProjP {
    static constexpr bool PERM = true;
    u16* hp; const LAS f32x2* tab;
    DI void operator()(const f32x4 (&acc)[2][2][4][2], const Unit& u, int wr, int wc, int fr, int fq) const {
        const int row0 = u.pm * BM + wr * 64 + fr;
        const bool hi = fq >= 2;
        const int fbase = 8 * (fq & 1);
#pragma unroll
        for (int bj = 0; bj < 2; ++bj) {
            const int cblk = u.pn * BM + bj * HALF + wc * 32;
            const int c64 = cblk & ~63;
            const bool rope_blk = (c64 < 640) || (c64 >= 768 && c64 < 1792);
            const bool colhalf = (cblk & 32) != 0;
#pragma unroll
            for (int ai = 0; ai < 2; ++ai) {
                if (!((u.rows >> ai) & 1)) continue;
#pragma unroll
                for (int m = 0; m < 4; ++m) {
                    const int row = row0 + ai * HALF + m * 16;
                    const int n = row % NTOK; const bool lat = n >= CTXL; const int s = lat ? n - CTXL : 0;
                    const int pos = colhalf ? (s & 63) : (s >> 6);
                    f32x4 v0 = acc[ai][bj][m][0], v1 = acc[ai][bj][m][1];
                    if (rope_blk) {
#pragma unroll
                        for (int j = 0; j < 4; ++j) {
                            const float p0 = __shfl_xor(v0[j], 32), p1 = __shfl_xor(v1[j], 32);
                            f32x2 c0 = tab[pos * 16 + fbase + j], c1 = tab[pos * 16 + fbase + 4 + j];
                            if (!lat) { c0 = (f32x2){1.f, 0.f}; c1 = (f32x2){1.f, 0.f}; }
                            v0[j] = hi ? (v0[j] * c0[0] + p0 * c0[1]) : (v0[j] * c0[0] - p0 * c0[1]);
                            v1[j] = hi ? (v1[j] * c1[0] + p1 * c1[1]) : (v1[j] * c1[0] - p1 * c1[1]);
                        }
                    }
                    *(u32x4*)(hp + (size_t)row * HPW + cblk + 8 * fq) = pack8(v0, v1);
                }
            }
        }
    }
};
struct EpiResidP {
    static constexpr bool PERM = false;
    float* z; const float* h; const float* modbase; int layer; bool lat;
    DI void operator()(const f32x4 (&acc)[2][2][4][2], const Unit& u, int wr, int wc, int fr, int fq) const {
        const int m0 = u.pm * BM; const int r0 = lat ? ((m0 >> 11) * NTOK + CTXL + (m0 & 2047)) : m0;
        const int row0 = r0 + wr * 64 + fr, col0 = u.pn * BM + wc * 32 + 4 * fq;
        const float* m2 = modbase + ((size_t)(layer * 9 + modrow_of(r0)) * 6 + 2) * 1024 + col0;
        f32x4 mm[2][2];
#pragma unroll
        for (int bj = 0; bj < 2; ++bj)
#pragma unroll
            for (int n = 0; n < 2; ++n) mm[bj][n] = *(const f32x4*)(m2 + bj * HALF + n * 16);
        f32x4 hc[2][2], hn[2][2];
#pragma unroll
        for (int bj = 0; bj < 2; ++bj)
#pragma unroll
            for (int n = 0; n < 2; ++n) hc[bj][n] = *(const f32x4*)(h + (size_t)row0 * D + col0 + bj * HALF + n * 16);
#pragma unroll
        for (int q = 0; q < 8; ++q) {
            const int ai = q >> 2, m = q & 3;
            const int row = row0 + ai * HALF + m * 16;
            const int qn = q < 7 ? q + 1 : 7;
            const int rown = row0 + (qn >> 2) * HALF + (qn & 3) * 16;
#pragma unroll
            for (int bj = 0; bj < 2; ++bj)
#pragma unroll
                for (int n = 0; n < 2; ++n) hn[bj][n] = *(const f32x4*)(h + (size_t)rown * D + col0 + bj * HALF + n * 16);
#pragma unroll
            for (int bj = 0; bj < 2; ++bj)
#pragma unroll
                for (int n = 0; n < 2; ++n)
                    if ((u.rows >> ai) & 1) *(f32x4*)(z + (size_t)row * D + col0 + bj * HALF + n * 16) = ALPHA * hc[bj][n] + mm[bj][n] * acc[ai][bj][m][n];
#pragma unroll
            for (int bj = 0; bj < 2; ++bj)
#pragma unroll
                for (int n = 0; n < 2; ++n) hc[bj][n] = hn[bj][n];
        }
    }
};

struct OrderRkvLora {
    Order o; int nM, extra;
    DI void init(int G, int c) { o.init(T, D, 3, G, c); nM = T / BM; extra = 3 * nM; }
    DI bool decode(long L, Unit& u) const {
        if (L < o.total) {
            u.g = (int)(L / o.per); int wgid = (int)(L - (long)u.g * o.per);
            { const int q = o.per / NXCD, r = o.per % NXCD, xcd = wgid % NXCD, off = wgid / NXCD; wgid = (xcd < r ? xcd * (q + 1) : r * (q + 1) + (xcd - r) * q) + off; }
            const int nig = WGM * o.nN, gid = wgid / nig, fm = gid * WGM, gsz = (o.nM - fm) < WGM ? (o.nM - fm) : WGM;
            u.pm = fm + ((wgid % nig) % gsz); u.pn = (wgid % nig) / gsz; return true;
        }
        const int Lx = (int)(L - o.total); if (Lx >= extra) return false;
        const int gg = Lx / nM; u.g = 3 + gg; u.pm = Lx - gg * nM; u.pn = 0; return true;
    }
    DI bool next(int i, Unit& u) const {
        const int U = o.total + extra, G = o.G, c = o.c, fr = U / G, rem = U - fr * G;
        const bool split = false;
        long L; int half = 3;
        if (!split || i < fr) { L = (long)i * G + c; if (L >= U) return false; }
        else { if (i > fr || c >= 2 * rem) return false; L = (long)fr * G + (c >> 1); half = 1 + (c & 1); }
        u.rows = half; return decode(L, u);
    }
};
struct AddrRkvLora {
    const unsigned char* ws;
    DI const char* a(const Unit& u) const {
        const int mi = u.g < 3 ? u.g + (u.g > 0 ? 1 : 0) : (u.g == 3 ? 1 : u.g);
        return (const char*)((const u16*)(ws + WS_XMIX) + ((size_t)mi * T + (size_t)u.pm * BM) * D);
    }
    DI const char* b(const Unit& u) const {
        const size_t off = u.g < 3 ? WB_RKV + ((size_t)u.g * D + (size_t)u.pn * BM) * D * 2 : (u.g == 3 ? WB_DEC1 : (u.g == 4 ? WB_ICL1 : WB_G1));
        return (const char*)(ws + off);
    }
};
DI f32x4 act4(f32x4 v, int act) {
    if (act == 1) {
#pragma unroll
        for (int e = 0; e < 4; ++e) v[e] = 1.f - 2.f / (1.f + __expf(2.f * v[e]));
    } else if (act == 2) {
#pragma unroll
        for (int e = 0; e < 4; ++e) v[e] = sigmoidf_(v[e]);
    }
    return v;
}
struct EpiRkvLora {
    static constexpr bool PERM = true;
    unsigned char* ws;
    DI void operator()(const f32x4 (&acc)[2][2][4][2], const Unit& u, int wr, int wc, int fr, int fq) const {
        const int row0 = u.pm * BM + wr * 64 + fr;
        if (u.g < 3) {
            u16* base = (u16*)(ws + WS_R + (size_t)u.g * (WS_K - WS_R));
            const int col0 = u.pn * BM + wc * 32 + 8 * fq;
#pragma unroll
            for (int ai = 0; ai < 2; ++ai)
#pragma unroll
                for (int m = 0; m < 4; ++m) { u16* rowp = base + (size_t)(row0 + ai * HALF + m * 16) * D + col0;
#pragma unroll
                    for (int bj = 0; bj < 2; ++bj) *(u32x4*)(rowp + bj * HALF) = pack8(acc[ai][bj][m][0], acc[ai][bj][m][1]); }
        } else {
            const int ld = u.g == 5 ? 192 : 128, nvalid = u.g == 5 ? 160 : 128;
            const size_t off = u.g == 3 ? WS_LW : (u.g == 4 ? WS_LA : WS_SG);
            const int act = u.g == 3 ? 1 : (u.g == 5 ? 2 : 0);
            u16* base = (u16*)(ws + off);
#pragma unroll
            for (int bj = 0; bj < 2; ++bj) {
                const int col = bj * HALF + wc * 32 + 8 * fq;
                if (col < ld) {
                    const bool zero = col >= nvalid;
#pragma unroll
                    for (int ai = 0; ai < 2; ++ai)
#pragma unroll
                        for (int m = 0; m < 4; ++m) {
                            f32x4 v0 = act4(acc[ai][bj][m][0], act), v1 = act4(acc[ai][bj][m][1], act);
                            if (zero) { v0 = (f32x4){0.f, 0.f, 0.f, 0.f}; v1 = v0; }
                            *(u32x4*)(base + (size_t)(row0 + ai * HALF + m * 16) * ld + col) = pack8(v0, v1);
                        }
                }
            }
        }
    }
};

struct ExpSched {
    const LAS int* pt; int NT, nsh, NPN, G, c;
    DI bool next(int i, Unit& u) const {
        const int U = (NT + nsh) * NPN, fr = U / G, rem = U - fr * G;
        const bool split = rem > 0 && 2 * rem <= G;
        int L, half = 3;
        if (!split || i < fr) { const long L_ = (long)i * G + c; if (L_ >= U) return false; L = (int)L_; }
        else { if (i > fr || c >= 2 * rem) return false; L = fr * G + (c >> 1); half = 1 + (c & 1); }
        const int rt = L / NPN; u.pm = rt; u.pn = L - rt * NPN;
        int e = 256, rows = 3;
        if (rt < NT) {
            int lo = 0, hi = 255; while (lo < hi) { const int mid = (lo + hi + 1) >> 1; if (pt[mid] <= rt) lo = mid; else hi = mid - 1; } e = lo;
            const int valid = (pt - 256)[e] - 256 * (rt - pt[e]);
            rows = valid <= 128 ? 1 : 3;
        }
        u.g = e; u.rows = rows & half; return true;
    }
};
struct AddrExp1 {
    const u16* ubuf; const int* arows; const u16* wt; int NT; bool lat;
    DI const char* a0() const { return (const char*)ubuf; }
    DI int arow(const Unit& u, int r) const {
        const int t = (u.pm - NT) * BM + r;
        const int idr = arows[(size_t)(u.pm < NT ? u.pm : 0) * BM + r];
        const int ids = lat ? ((t >> 11) * NTOK + CTXL + (t & 2047)) : t;
        return (u.pm < NT) ? idr : ids;
    }
    DI const char* b(const Unit& u) const { return (const char*)(wt + ((size_t)u.g * 512 + (size_t)u.pn * BM) * 1024); }
};
struct EpiExpH {
    static constexpr bool PERM = true;
    u16* hg; int NT;
    DI void operator()(const f32x4 (&acc)[2][2][4][2], const Unit& u, int wr, int wc, int fr, int fq) const {
        const size_t hrow0 = (u.pm < NT) ? (size_t)u.pm * BM : (size_t)NPMAX + (size_t)(u.pm - NT) * BM;
        const int col0 = u.pn * HALF + wc * 32 + 8 * fq;
#pragma unroll
        for (int ai = 0; ai < 2; ++ai) {
            if (!((u.rows >> ai) & 1)) continue;
#pragma unroll
            for (int m = 0; m < 4; ++m) {
                f32x4 h0, h1;
#pragma unroll
                for (int j = 0; j < 4; ++j) { h0[j] = siluf_(acc[ai][0][m][0][j]) * acc[ai][1][m][0][j]; h1[j] = siluf_(acc[ai][0][m][1][j]) * acc[ai][1][m][1][j]; }
                *(u32x4*)(hg + (hrow0 + (size_t)(ai * HALF + wr * 64 + m * 16 + fr)) * 256 + col0) = pack8(h0, h1);
            }
        }
    }
};
struct AddrExp2 {
    const u16* hg; const u16* wt; int NT;
    DI const char* a(const Unit& u) const { const size_t hrow0 = (u.pm < NT) ? (size_t)u.pm * BM : (size_t)NPMAX + (size_t)(u.pm - NT) * BM; return (const char*)(hg + hrow0 * 256); }
    DI const char* b(const Unit& u) const { return (const char*)(wt + ((size_t)u.g * 1024 + (size_t)u.pn * BM) * 256); }
};
struct EpiExpOut {
    static constexpr bool PERM = true;
    u16* slotb; long shoff; const int* rtk; const float* rw; int NT;
    LAS u32x2* tab;
    struct Pre { int r; float w; };
    DI Pre prefetch(const Unit& u) const {
        const int tid = threadIdx.x & 255; const bool routed = u.pm < NT;
        const size_t sr = (size_t)(routed ? u.pm : 0) * BM + tid;
        const int ortk = rtk[sr]; const float ow = rw[sr];
        Pre q; q.r = routed ? ortk : (u.pm - NT) * BM + tid; q.w = routed ? ow : 1.f; return q;
    }
    DI void commit(const Pre& q, int buf) const { if (threadIdx.x < 256) tab[buf * 256 + threadIdx.x] = (u32x2){(unsigned)q.r, __float_as_uint(q.w)}; }
    DI void operator()(const f32x4 (&acc)[2][2][4][2], const Unit& u, int wr, int wc, int fr, int fq, int buf) const {
        const bool routed = u.pm < NT;
        const int col0 = u.pn * BM + wc * 32 + 8 * fq;
        const int lr0 = wr * 64 + fr;
        u16* base = slotb + (routed ? 0L : shoff) + col0;
#pragma unroll
        for (int ai = 0; ai < 2; ++ai) {
            if (!((u.rows >> ai) & 1)) continue;
#pragma unroll
            for (int m = 0; m < 4; ++m) {
                const u32x2 e = tab[buf * 256 + lr0 + ai * HALF + m * 16];
                const int orow = (int)e[0]; const float w = __uint_as_float(e[1]);
                if (orow >= 0) {
#pragma unroll
                    for (int bj = 0; bj < 2; ++bj) *(u32x4*)(base + (size_t)orow * D + bj * HALF) = pack8(acc[ai][bj][m][0] * w, acc[ai][bj][m][1] * w);
                }
            }
        }
    }
};
}

DI void phase_ada(const Params& p, ldsp lds) {
    LAS float* cact = (LAS float*)(lds + LDS_BASE);
    LAS float* red = cact + 9 * 1024;
    const int tid = threadIdx.x, lane = tid & 63, wave = tid >> 6;
    float* mods = (float*)(p.ws + WS_MODS);
    if (blockIdx.x < 192) {
        for (int i = tid; i < 9 * 1024; i += NTHR) { const float x = (i < 8192) ? p.in[1][i] : p.in[3][i - 8192]; cact[i] = siluf_(x); }
    }
    __syncthreads();
    for (int u = blockIdx.x; u < 192; u += gridDim.x) {
        const int layer = u / 96, slice = u - layer * 96;
        const float* W = p.in[4] + (size_t)layer * 1024 * 6144 + slice * 64;
        const int c4 = tid & 15, kg = tid >> 4;
        f32x4 acc[9];
#pragma unroll
        for (int r = 0; r < 9; ++r) acc[r] = (f32x4){0.f, 0.f, 0.f, 0.f};
#pragma unroll
        for (int hb = 0; hb < 2; ++hb) {
            f32x4 wv[16];
#pragma unroll
            for (int i = 0; i < 16; ++i) wv[i] = *(const f32x4*)(W + (size_t)(kg + 32 * (hb * 16 + i)) * 6144 + c4 * 4);
#pragma unroll
            for (int i = 0; i < 16; ++i) {
                const int k = kg + 32 * (hb * 16 + i);
#pragma unroll
                for (int r = 0; r < 9; ++r) acc[r] += cact[r * 1024 + k] * wv[i];
            }
        }
#pragma unroll
        for (int r = 0; r < 9; ++r)
#pragma unroll
            for (int e = 0; e < 4; ++e) { float v = acc[r][e]; v += __shfl_xor(v, 16); v += __shfl_xor(v, 32); acc[r][e] = v; }
        if (lane < 16) {
#pragma unroll
            for (int r = 0; r < 9; ++r) *(LAS f32x4*)(red + (wave * 9 + r) * 64 + c4 * 4) = acc[r];
        }
        __syncthreads();
        for (int i = tid; i < 576; i += NTHR) {
            const int r = i >> 6, col = i & 63;
            float s = 0.f;
#pragma unroll
            for (int w = 0; w < 8; ++w) s += red[(w * 9 + r) * 64 + col];
            s += p.in[5][layer * 6144 + slice * 64 + col];
            mods[(size_t)(layer * 9 + r) * 6144 + slice * 64 + col] = s;
        }
        __syncthreads();
    }
}


DI void cvt_tr(ldsp lds, const float* src, int lds_, int K, int N, int Kp, int Np, u16* dst, int dn0, int boff = 0) {
    LAS float* tile = (LAS float*)(lds + LDS_BASE);
    const int tid = threadIdx.x;
    const int tk = (Kp + 63) >> 6, tn = (Np + 63) >> 6;
    const int G_ = (int)gridDim.x;
    for (int t = ((int)blockIdx.x + G_ - boff % G_) % G_; t < tk * tn; t += G_) {
        const int k0 = (t / tn) * 64, n0 = (t % tn) * 64;
        __syncthreads();
#pragma unroll
        for (int j = 0; j < 8; ++j) {
            const int e = tid + 512 * j, kk = e >> 6, nn = e & 63;
            float v = 0.f;
            if (k0 + kk < K && n0 + nn < N) v = src[(size_t)(k0 + kk) * lds_ + n0 + nn];
            tile[kk * 65 + nn] = v;
        }
        __syncthreads();
#pragma unroll
        for (int j = 0; j < 8; ++j) {
            const int e = tid + 512 * j, nn = e >> 6, kk = e & 63;
            if (k0 + kk < Kp && n0 + nn < Np) dst[(size_t)(dn0 + n0 + nn) * Kp + k0 + kk] = f2bf(tile[kk * 65 + nn]);
        }
    }
}
DI void cvt_rows(const float* src, u16* dst, size_t n4, size_t gtid, size_t gsz) {
    for (size_t i = gtid; i < n4; i += gsz) {
        const f32x4 v = *(const f32x4*)(src + i * 4);
        u32x2 o; o[0] = pack2(v[0], v[1]); o[1] = pack2(v[2], v[3]);
        *(u32x2*)(dst + i * 4) = o;
    }
}
struct DStrip { const float* src; u16* dst; int N, k0, n0; };
DI DStrip dense_strip(const Params& p, int s) {
    s = s < 464 ? s : 463;
    DStrip d; int t;
    if (s < 144) { d.src = p.in[8]; d.dst = (u16*)(p.ws + WB_WIN); d.N = 2304; t = s; d.k0 = (t / 9) * 64; d.n0 = (t % 9) * 256; return d; }
    s -= 144; const int m = s >> 6; t = s & 63; d.N = 1024; d.k0 = (t >> 2) * 64; d.n0 = (t & 3) * 256;
    d.src = m == 0 ? p.in[9] : (m < 4 ? p.in[14] + (size_t)(m - 1) * 1024 * 1024 : p.in[15]);
    const size_t off = m == 0 ? WB_WOUT : (m < 4 ? WB_RKV + (size_t)(m - 1) * 1024 * 1024 * 2 : WB_RKO);
    d.dst = (u16*)(p.ws + off); return d;
}
DI void dense_ld(const Params& p, int s, f32x4 (&v)[8]) {
    const DStrip d = dense_strip(p, s);
    const int tid = threadIdx.x, w = tid >> 6, kb = (tid & 63) >> 3, ng = tid & 7;
    const float* q = d.src + (size_t)(d.k0 + 8 * kb) * d.N + d.n0 + 32 * w + 4 * ng;
#pragma unroll
    for (int j = 0; j < 8; ++j) v[j] = *(const f32x4*)(q + (size_t)j * d.N);
}
DI void dense_st(const Params& p, int s, const f32x4 (&v)[8]) {
    if (s >= 464) return;
    const DStrip d = dense_strip(p, s);
    const int tid = threadIdx.x, w = tid >> 6, kb = (tid & 63) >> 3, ng = tid & 7;
#pragma unroll
    for (int i = 0; i < 4; ++i)
        *(u32x4*)(d.dst + (size_t)(d.n0 + 32 * w + 4 * ng + i) * 1024 + d.k0 + 8 * kb) = (u32x4){pack2(v[0][i], v[1][i]), pack2(v[2][i], v[3][i]), pack2(v[4][i], v[5][i]), pack2(v[6][i], v[7][i])};
}
DI void phase_cvt(const Params& p, ldsp lds) {
    {
        const int G = (int)gridDim.x; int s0 = (int)blockIdx.x, s1 = s0 + G;
        f32x4 v0[8], v1[8];
        dense_ld(p, s0, v0); dense_ld(p, s1, v1);
        while (s0 < 464) {
            dense_st(p, s0, v0); s0 += 2 * G; dense_ld(p, s0, v0);
            dense_st(p, s1, v1); s1 += 2 * G; dense_ld(p, s1, v1);
        }
    }
    int bo = 0;
    for (int d = 0; d < 2; ++d) {
        cvt_tr(lds, p.in[17] + (size_t)d * 1024 * 64, 64, 1024, 64, 1024, d ? 192 : 64, (u16*)(p.ws + WB_DEC1), d * 64, bo); bo += d ? 48 : 16;
        cvt_tr(lds, p.in[20] + (size_t)d * 1024 * 64, 64, 1024, 64, 1024, d ? 192 : 64, (u16*)(p.ws + WB_ICL1), d * 64, bo); bo += d ? 48 : 16;
        cvt_tr(lds, p.in[18] + (size_t)d * 64 * 1024, 1024, 64, 1024, 64, 1024, (u16*)(p.ws + WB_DEC2) + (size_t)d * 1024 * 64, 0, bo); bo += 16;
        cvt_tr(lds, p.in[21] + (size_t)d * 64 * 1024, 1024, 64, 1024, 64, 1024, (u16*)(p.ws + WB_ICL2) + (size_t)d * 1024 * 64, 0, bo); bo += 16;
    }
    cvt_tr(lds, p.in[22], 160, 1024, 160, 1024, 256, (u16*)(p.ws + WB_G1), 0, bo); bo += 64;
    cvt_tr(lds, p.in[23], 1024, 160, 1024, 192, 1024, (u16*)(p.ws + WB_G2), 0, bo);
}


DI void phase_cvt_experts(const Params& p, ldsp lds) {
    LAS float* tl = (LAS float*)(lds + LDS_BASE);
    const int tid = threadIdx.x;
    const int nstrip = 2 * 257 * 48;
    f32x4 ra[8], rb[8];
#define CE_DECODE(st, src, ld, k0, n0, dst, dld, isin) \
        const int le_ = (st) / 48, r_ = (st) - le_ * 48; const int layer_ = le_ / 257, e_ = le_ - layer_ * 257; \
        const bool isin = r_ < 32; \
        const int k0 = isin ? (r_ >> 1) * 64 : ((r_ - 32) >> 2) * 64, n0 = isin ? (r_ & 1) * 256 : ((r_ - 32) & 3) * 256; \
        const float* src = isin ? ((e_ < 256) ? p.in[30] + ((size_t)layer_ * 256 + e_) * 1024 * 512 : p.in[32] + (size_t)layer_ * 1024 * 512) \
                                : ((e_ < 256) ? p.in[31] + ((size_t)layer_ * 256 + e_) * 256 * 1024 : p.in[33] + (size_t)layer_ * 256 * 1024); \
        const int ld = isin ? 512 : 1024; \
        u16* dst = isin ? (u16*)(p.ws + WT_IN) + ((size_t)layer_ * 257 + e_) * 512 * 1024 : (u16*)(p.ws + WT_OUT) + ((size_t)layer_ * 257 + e_) * 1024 * 256; \
        const int dld = isin ? 1024 : 256;
#define CE_LOAD(R, st) do { const int sc_ = (st) < nstrip ? (st) : nstrip - 1; CE_DECODE(sc_, src_, ld_, k0_, n0_, dst_, dld_, isin_) (void)dst_; (void)dld_; (void)isin_; \
        _Pragma("unroll") for (int q = 0; q < 8; ++q) R[q] = *(const f32x4*)(src_ + (size_t)(k0_ + (tid >> 6) + 8 * q) * ld_ + n0_ + (tid & 63) * 4); } while (0)
#define CE_DRAIN(R, st) do { \
        __syncthreads(); \
        _Pragma("unroll") for (int q = 0; q < 8; ++q) *(LAS f32x4*)(tl + ((tid >> 6) + 8 * q) * 260 + (tid & 63) * 4) = R[q]; \
        __syncthreads(); \
        if ((st) < nstrip) { CE_DECODE(st, src_, ld_, k0_, n0_, dst_, dld_, isin_) (void)src_; (void)ld_; \
            _Pragma("unroll") for (int q = 0; q < 4; ++q) { const int id_ = tid + 512 * q, n_ = id_ & 255, c_ = id_ >> 8; \
                float v_[8]; _Pragma("unroll") for (int j = 0; j < 8; ++j) v_[j] = tl[(c_ * 8 + j) * 260 + n_]; \
                const int nn_ = n0_ + n_; \
                const int rho_ = isin_ ? (((nn_ & 255) >> 7) * 256 + (nn_ >> 8) * 128 + (nn_ & 127)) : nn_; \
                *(u32x4*)(dst_ + (size_t)rho_ * dld_ + k0_ + c_ * 8) = (u32x4){pack2(v_[0], v_[1]), pack2(v_[2], v_[3]), pack2(v_[4], v_[5]), pack2(v_[6], v_[7])}; } } } while (0)
    int st = blockIdx.x;
    CE_LOAD(ra, st); CE_LOAD(rb, st + (int)gridDim.x);
    for (; st < nstrip; st += 2 * (int)gridDim.x) {
        CE_DRAIN(ra, st); CE_LOAD(ra, st + 2 * (int)gridDim.x);
        CE_DRAIN(rb, st + (int)gridDim.x); CE_LOAD(rb, st + 3 * (int)gridDim.x);
    }
#undef CE_DECODE
#undef CE_LOAD
#undef CE_DRAIN
}

DI void phase_mod0(const Params& p) {
    const int lane = threadIdx.x & 63, wave = threadIdx.x >> 6;
    float* hbuf = (float*)(p.ws + WS_H); u16* ubuf = (u16*)(p.ws + WS_U);
    const int stride = (int)gridDim.x * 8;
#define MOD0_SRC(row_) ({ const int b_ = (row_) / NTOK, n_ = (row_) - b_ * NTOK; \
        (n_ < CTXL) ? p.in[2] + ((size_t)b_ * CTXL + n_) * D : p.in[0] + ((size_t)b_ * SEQ + (n_ - CTXL)) * D; })
    f32x4 nh[4];
    {
        const int r0 = blockIdx.x * 8 + wave; const int rc = r0 < T ? r0 : T - 1;
        const float* src = MOD0_SRC(rc);
#pragma unroll
        for (int j = 0; j < 4; ++j) nh[j] = *(const f32x4*)(src + lane * 4 + 256 * j);
    }
    for (int row = blockIdx.x * 8 + wave; row < T; row += stride) {
        const int b = row / NTOK, n = row - b * NTOK;
        const int mr = (n < CTXL) ? 8 : b;
        const float* m0 = mods_ptr(p, 0, mr, 0); const float* m1 = mods_ptr(p, 0, mr, 1);
        f32x4 h[4];
#pragma unroll
        for (int j = 0; j < 4; ++j) h[j] = nh[j];
        {
            const int rn = (row + stride < T) ? row + stride : row;
            const float* srcn = MOD0_SRC(rn);
#pragma unroll
            for (int j = 0; j < 4; ++j) nh[j] = *(const f32x4*)(srcn + lane * 4 + 256 * j);
        }
#pragma unroll
        for (int j = 0; j < 4; ++j) {
            const int col = lane * 4 + 256 * j;
            const f32x4 a = *(const f32x4*)(m0 + col), s = *(const f32x4*)(m1 + col);
            const f32x4 u = h[j] * (1.f + s) + a;
            *(f32x4*)(hbuf + (size_t)row * D + col) = h[j];
            u32x2 o; o[0] = pack2(u[0], u[1]); o[1] = pack2(u[2], u[3]);
            *(u32x2*)(ubuf + (size_t)row * D + col) = o;
        }
    }
#undef MOD0_SRC
}

DI void ld_bf8(const u16* p, f32x4& a, f32x4& b) {
    const u32x4 v = *(const u32x4*)p;
    a = (f32x4){__uint_as_float(v[0] << 16), __uint_as_float(v[0] & 0xffff0000u), __uint_as_float(v[1] << 16), __uint_as_float(v[1] & 0xffff0000u)};
    b = (f32x4){__uint_as_float(v[2] << 16), __uint_as_float(v[2] & 0xffff0000u), __uint_as_float(v[3] << 16), __uint_as_float(v[3] & 0xffff0000u)};
}
template <int MODE>
DI void phase_ln(const Params& p, int layer, bool lat_only) {
    const int lane = threadIdx.x & 63, wave = threadIdx.x >> 6;
    float* hbuf = (float*)(p.ws + WS_H); u16* ubuf = (u16*)(p.ws + WS_U);
    float* zbuf = (float*)(p.ws + WS_Z);
    const int nrows = lat_only ? TL : T;
    const int which = (MODE == 0) ? 0 : 1;
    const float* g = p.in[6] + (size_t)(layer * 2 + which) * D; const float* bb = p.in[7] + (size_t)(layer * 2 + which) * D;
    f32x4 nx[2][2];
    if (MODE == 0) {
        const int m0_ = blockIdx.x * 8 + wave; const int mc_ = m0_ < nrows ? m0_ : nrows - 1;
        const int r0_ = lat_only ? ((mc_ >> 11) * NTOK + CTXL + (mc_ & 2047)) : mc_;
#pragma unroll
        for (int j = 0; j < 2; ++j) { nx[j][0] = *(const f32x4*)(zbuf + (size_t)r0_ * D + lane * 8 + 512 * j); nx[j][1] = *(const f32x4*)(zbuf + (size_t)r0_ * D + lane * 8 + 512 * j + 4); }
    }
    for (int m = blockIdx.x * 8 + wave; m < nrows; m += gridDim.x * 8) {
        const int row = lat_only ? ((m >> 11) * NTOK + CTXL + (m & 2047)) : m;
        const int mr = modrow_of(row);
        f32x4 x[2][2];
        float s = 0.f;
        if (MODE == 0) {
            const int mn_ = (m + (int)gridDim.x * 8 < nrows) ? m + (int)gridDim.x * 8 : m;
            const int rn_ = lat_only ? ((mn_ >> 11) * NTOK + CTXL + (mn_ & 2047)) : mn_;
#pragma unroll
            for (int j = 0; j < 2; ++j) { x[j][0] = nx[j][0]; x[j][1] = nx[j][1]; }
#pragma unroll
            for (int j = 0; j < 2; ++j) { nx[j][0] = *(const f32x4*)(zbuf + (size_t)rn_ * D + lane * 8 + 512 * j); nx[j][1] = *(const f32x4*)(zbuf + (size_t)rn_ * D + lane * 8 + 512 * j + 4); }
        }
#pragma unroll
        for (int j = 0; j < 2; ++j) {
            const int col = lane * 8 + 512 * j;
            if (MODE == 0) { }
            else {
                const f32x4 h0 = *(const f32x4*)(hbuf + (size_t)row * D + col), h1 = *(const f32x4*)(hbuf + (size_t)row * D + col + 4);
                f32x4 a0, a1; ld_bf8((const u16*)(p.ws + WS_SH) + (size_t)m * D + col, a0, a1);
#pragma unroll
                for (int k8 = 0; k8 < 8; ++k8) { f32x4 t0, t1; ld_bf8((const u16*)(p.ws + WS_SLOT) + ((size_t)m * 8 + k8) * D + col, t0, t1); a0 += t0; a1 += t1; }
                const float* m5 = mods_ptr(p, layer, mr, 5) + col;
                x[j][0] = ALPHA * h0 + *(const f32x4*)m5 * a0; x[j][1] = ALPHA * h1 + *(const f32x4*)(m5 + 4) * a1;
            }
#pragma unroll
            for (int q = 0; q < 2; ++q) s += x[j][q][0] + x[j][q][1] + x[j][q][2] + x[j][q][3];
        }
        const float mu = wsum64(s) * (1.f / D);
        float v = 0.f;
#pragma unroll
        for (int j = 0; j < 2; ++j)
#pragma unroll
            for (int q = 0; q < 2; ++q) { const f32x4 d = x[j][q] - mu; v += d[0] * d[0] + d[1] * d[1] + d[2] * d[2] + d[3] * d[3]; }
        const float rs = rsqrtf(wsum64(v) * (1.f / D) + LN_EPS);
#pragma unroll
        for (int j = 0; j < 2; ++j) {
            const int col = lane * 8 + 512 * j;
            f32x4 hn[2];
#pragma unroll
            for (int q = 0; q < 2; ++q) hn[q] = (x[j][q] - mu) * rs * *(const f32x4*)(g + col + 4 * q) + *(const f32x4*)(bb + col + 4 * q);
            if (MODE == 0) {
                *(f32x4*)(hbuf + (size_t)row * D + col) = hn[0]; *(f32x4*)(hbuf + (size_t)row * D + col + 4) = hn[1];
                const float* m4 = mods_ptr(p, layer, mr, 4) + col; const float* m3 = mods_ptr(p, layer, mr, 3) + col;
                const f32x4 u0 = hn[0] * (1.f + *(const f32x4*)m4) + *(const f32x4*)m3, u1 = hn[1] * (1.f + *(const f32x4*)(m4 + 4)) + *(const f32x4*)(m3 + 4);
                *(u32x4*)(ubuf + (size_t)row * D + col) = pack8(u0, u1);
            } else if (MODE == 1) {
                *(f32x4*)(hbuf + (size_t)row * D + col) = hn[0]; *(f32x4*)(hbuf + (size_t)row * D + col + 4) = hn[1];
                const float* m1 = mods_ptr(p, layer + 1, mr, 1) + col; const float* m0 = mods_ptr(p, layer + 1, mr, 0) + col;
                *(f32x4*)(zbuf + (size_t)row * D + col) = hn[0] * (1.f + *(const f32x4*)m1) + *(const f32x4*)m0;
                *(f32x4*)(zbuf + (size_t)row * D + col + 4) = hn[1] * (1.f + *(const f32x4*)(m1 + 4)) + *(const f32x4*)(m0 + 4);
            } else {
                *(f32x4*)(p.out + (size_t)m * D + col) = hn[0]; *(f32x4*)(p.out + (size_t)m * D + col + 4) = hn[1];
            }
        }
    }
}


constexpr int BG_NV = 8;
constexpr int BG_NSTRIP = 2 * 257 * 48;
struct BgCvt { int st, pst, lim, stride; f32x4 pend[BG_NV]; };
struct BgStrip { const float* src; u16* dst; int ld, dld, k0, n0; bool isin; };
DI BgStrip bg_decode(const Params& p, int st, int lim) {
    st = st < 0 ? 0 : (st < lim ? st : lim - 1);
    BgStrip d;
    const int le = st / 48, r = st - le * 48; const int layer = le / 257, e = le - layer * 257;
    d.isin = r < 32;
    d.k0 = d.isin ? (r >> 1) * 64 : ((r - 32) >> 2) * 64; d.n0 = d.isin ? (r & 1) * 256 : ((r - 32) & 3) * 256;
    d.src = d.isin ? ((e < 256) ? p.in[30] + ((size_t)layer * 256 + e) * 1024 * 512 : p.in[32] + (size_t)layer * 1024 * 512)
                   : ((e < 256) ? p.in[31] + ((size_t)layer * 256 + e) * 256 * 1024 : p.in[33] + (size_t)layer * 256 * 1024);
    d.ld = d.isin ? 512 : 1024;
    d.dst = d.isin ? (u16*)(p.ws + WT_IN) + ((size_t)layer * 257 + e) * 512 * 1024 : (u16*)(p.ws + WT_OUT) + ((size_t)layer * 257 + e) * 1024 * 256;
    d.dld = d.isin ? 1024 : 256;
    return d;
}
DI void bg_load(const Params& p, BgCvt& c) {
    const BgStrip d = bg_decode(p, c.st, c.lim);
    const int tid = threadIdx.x, w = tid >> 6, kb = (tid & 63) >> 3, ng = tid & 7;
    const float* s = d.src + (size_t)(d.k0 + 8 * kb) * d.ld + d.n0 + 32 * w + 4 * ng;
#pragma unroll
    for (int j = 0; j < BG_NV; ++j) c.pend[j] = __builtin_nontemporal_load((const f32x4*)(s + (size_t)j * d.ld));
    c.pst = c.st; c.st += c.stride;
}
DI void bg_store(const Params& p, BgCvt& c) {
    const BgStrip d = bg_decode(p, c.pst, c.lim);
    const int tid = threadIdx.x, w = tid >> 6, kb = (tid & 63) >> 3, ng = tid & 7;
    const int nkt = d.dld >> 6, kt = d.k0 >> 6;
    if (c.pst < 0 || c.pst >= c.lim) return;
#pragma unroll
    for (int i = 0; i < 4; ++i) {
        const int nn = d.n0 + 32 * w + 4 * ng + i;
        const int rho = d.isin ? (((nn & 255) >> 7) * 256 + (nn >> 8) * 128 + (nn & 127)) : nn;
        __builtin_nontemporal_store((u32x4){pack2(c.pend[0][i], c.pend[1][i]), pack2(c.pend[2][i], c.pend[3][i]), pack2(c.pend[4][i], c.pend[5][i]), pack2(c.pend[6][i], c.pend[7][i])},
                                    (u32x4*)(d.dst + ((size_t)((rho >> 8) * nkt + kt) * 256 + (rho & 255)) * 64 + 8 * kb));
    }
}
DI BgCvt bg_make(const Params& p, int start, int lim, int stride) { BgCvt c; c.st = start; c.pst = start; c.lim = lim; c.stride = stride; bg_load(p, c); return c; }
constexpr int BG_Q = 14;
DI int bg_idle(int ntiles) { const int i_ = (int)gridDim.x - ntiles; return i_ > 0 ? i_ : 0; }
DI int bg_s2() { return BG_NSTRIP - BG_Q * bg_idle(TL / 128); }
DI int bg_s1() { return bg_s2() - BG_Q * bg_idle(T / 128); }
DI void bg_idle_run(const Params& p, int ntiles, int lo, int hi) {
    const int nm = bg_idle(ntiles), mem = (int)blockIdx.x - ntiles;
    if (mem < 0 || lo >= hi) return;
    BgCvt c0 = bg_make(p, lo + mem, hi, 2 * nm), c1 = bg_make(p, lo + mem + nm, hi, 2 * nm);
    while (c0.pst + c0.stride < c0.lim || c1.pst + c1.stride < c1.lim) {
        bg_store(p, c0); bg_load(p, c0); bg_store(p, c1); bg_load(p, c1);
    }
    bg_store(p, c0); bg_store(p, c1);
}
DI void bg_step(const Params& p, BgCvt& c) { bg_store(p, c); bg_load(p, c); }
DI void bg_finish(const Params& p, BgCvt& c) { while (c.pst + c.stride < c.lim) bg_step(p, c); bg_store(p, c); }

constexpr int K_STR = 144;
template <bool ISB>
DI void attn_unit(const Params& p, ldsp lds, BgCvt& bgc, const u16* hp, int b, int ntiles, int nlin, int win_n0, bool use_mask, int qn,
                  const int* qcol, const int* kcol, int vcol, f32x4 (&O)[ISB ? 2 : 1][ISB ? 8 : 4], float* lsum, float* mrun) {
    constexpr int NM = ISB ? 2 : 1, DV = ISB ? 128 : 64, NDT = DV / 16, VSTR = (DV + 8) * 2, NVC = ISB ? 2 : 1;
    const int tid = threadIdx.x, lane = tid & 63, g = lane >> 4;
    ldsp Ks = lds + LDS_BASE;
    ldsp Vs = Ks + 2 * 64 * K_STR;
    const float sc = 0.125f * L2E;
    s16x8 qf[NM][2];
#pragma unroll
    for (int m = 0; m < NM; ++m)
#pragma unroll
        for (int ks = 0; ks < 2; ++ks)
            qf[m][ks] = *(const s16x8*)(hp + (size_t)(b * NTOK + qn) * HPW + qcol[m] + ks * 32 + g * 8);
#pragma unroll
    for (int m = 0; m < NM; ++m) {
        lsum[m] = 0.f; mrun[m] = -1e30f;
#pragma unroll
        for (int dt = 0; dt < NDT; ++dt) O[m][dt] = (f32x4){0.f, 0.f, 0.f, 0.f};
    }
    u32x4 rk[NM], rv[NVC];
#define N0_OF(ti) ((ti) < nlin ? (ti) * 64 : win_n0 + ((ti) - nlin) * 64)
    {
        const int n0 = N0_OF(0);
#pragma unroll
        for (int m = 0; m < NM; ++m) rk[m] = *(const u32x4*)(hp + (size_t)(b * NTOK + n0 + (tid >> 3)) * HPW + kcol[m] + (tid & 7) * 8);
#pragma unroll
        for (int s = 0; s < NVC; ++s) {
            const int c = tid + 512 * s; const int key = ISB ? (c >> 4) : (c >> 3), ch = ISB ? (c & 15) : (c & 7);
            rv[s] = *(const u32x4*)(hp + (size_t)(b * NTOK + n0 + key) * HPW + vcol + ch * 8);
        }
    }
    for (int ti = 0; ti < ntiles; ++ti) {
        const int n0 = N0_OF(ti);
        __syncthreads();
#pragma unroll
        for (int m = 0; m < NM; ++m) *(LAS u32x4*)(Ks + m * 64 * K_STR + (tid >> 3) * K_STR + (tid & 7) * 16) = rk[m];
#pragma unroll
        for (int s = 0; s < NVC; ++s) {
            const int c = tid + 512 * s; const int key = ISB ? (c >> 4) : (c >> 3), ch = ISB ? (c & 15) : (c & 7);
            *(LAS u32x4*)(Vs + key * VSTR + ch * 16) = rv[s];
        }
        __syncthreads();
        {
            const int tn_ = (ti + 1 < ntiles) ? ti + 1 : ntiles - 1;
            const int n1 = N0_OF(tn_);
#pragma unroll
            for (int m = 0; m < NM; ++m) rk[m] = *(const u32x4*)(hp + (size_t)(b * NTOK + n1 + (tid >> 3)) * HPW + kcol[m] + (tid & 7) * 8);
#pragma unroll
            for (int s = 0; s < NVC; ++s) {
                const int c = tid + 512 * s; const int key = ISB ? (c >> 4) : (c >> 3), ch = ISB ? (c & 15) : (c & 7);
                rv[s] = *(const u32x4*)(hp + (size_t)(b * NTOK + n1 + key) * HPW + vcol + ch * 8);
            }
        }
        bg_step(p, bgc);
        const bool masked = use_mask && (ti >= nlin);
        s16x8 pf[NM][2];
#pragma unroll
        for (int m = 0; m < NM; ++m) {
            f32x4 st[4];
#pragma unroll
            for (int kt = 0; kt < 4; ++kt) {
                st[kt] = (f32x4){0.f, 0.f, 0.f, 0.f};
#pragma unroll
                for (int ks = 0; ks < 2; ++ks) {
                    const s16x8 a = *(const LAS s16x8*)(Ks + m * 64 * K_STR + (kt * 16 + (lane & 15)) * K_STR + ks * 64 + g * 16);
                    st[kt] = __builtin_amdgcn_mfma_f32_16x16x32_bf16(a, qf[m][ks], st[kt], 0, 0, 0);
                }
            }
            float mx = -1e30f;
#pragma unroll
            for (int kt = 0; kt < 4; ++kt)
#pragma unroll
                for (int i = 0; i < 4; ++i) {
                    float s2 = st[kt][i] * sc;
                    if (masked) {
                        const int kpos = n0 - CTXL + kt * 16 + g * 4 + i, qpos = qn - CTXL;
                        const int dd = qpos - kpos;
                        if (dd > 128 || dd < -128) s2 = -1e30f;
                    }
                    st[kt][i] = s2; mx = fmaxf(mx, s2);
                }
            mx = fmaxf(mx, __shfl_xor(mx, 16)); mx = fmaxf(mx, __shfl_xor(mx, 32));
            const float mnew = fmaxf(mrun[m], mx);
            const float alpha = __builtin_amdgcn_exp2f(mrun[m] - mnew);
            mrun[m] = mnew;
            float ps = 0.f;
#pragma unroll
            for (int kt = 0; kt < 4; ++kt)
#pragma unroll
                for (int i = 0; i < 4; ++i) { const float pv = __builtin_amdgcn_exp2f(st[kt][i] - mnew); st[kt][i] = pv; ps += pv; }
            lsum[m] = lsum[m] * alpha + ps;
#pragma unroll
            for (int dt = 0; dt < NDT; ++dt) O[m][dt] *= alpha;
#pragma unroll
            for (int k2 = 0; k2 < 2; ++k2) {
                const unsigned w0 = pack2(st[2 * k2][0], st[2 * k2][1]), w1 = pack2(st[2 * k2][2], st[2 * k2][3]);
                const unsigned w2 = pack2(st[2 * k2 + 1][0], st[2 * k2 + 1][1]), w3 = pack2(st[2 * k2 + 1][2], st[2 * k2 + 1][3]);
                const u32x4 w = (u32x4){w0, w1, w2, w3};
                pf[m][k2] = __builtin_bit_cast(s16x8, w);
            }
        }
        const LAS unsigned char* vb = Vs + (4 * g + ((lane >> 2) & 3)) * VSTR + (4 * (lane & 3)) * 2;
#pragma unroll
        for (int dt = 0; dt < NDT; ++dt)
#pragma unroll
            for (int k2 = 0; k2 < 2; ++k2) {
                const s16x4 lo = vtr(vb + (32 * k2) * VSTR + dt * 32);
                const s16x4 hi = vtr(vb + (32 * k2 + 16) * VSTR + dt * 32);
                const s16x8 vf = (s16x8){lo[0], lo[1], lo[2], lo[3], hi[0], hi[1], hi[2], hi[3]};
#pragma unroll
                for (int m = 0; m < NM; ++m) O[m][dt] = __builtin_amdgcn_mfma_f32_16x16x32_bf16(vf, pf[m][k2], O[m][dt], 0, 0, 0);
            }
    }
#pragma unroll
    for (int m = 0; m < NM; ++m) { float l = lsum[m]; l += __shfl_xor(l, 16); l += __shfl_xor(l, 32); lsum[m] = l; }
}

DI void phase_attn(const Params& p, ldsp lds) {
    const int tid = threadIdx.x, lane = tid & 63, wave = tid >> 6, g = lane >> 4;
    const u16* hp = (const u16*)(p.ws + WS_HP);
    u16* ao = (u16*)(p.ws + WS_AO);
    float lam;
    {
        const float* lv = p.in[11];
        float d0 = 0.f, d1 = 0.f;
        for (int i = 0; i < 64; ++i) { d0 += lv[i] * lv[64 + i]; d1 += lv[128 + i] * lv[192 + i]; }
        lam = expf(d0) - expf(d1) + 0.2f;
    }
    const int NU_BL = 512, NU_AL = 1024, NU_BC = 64, NU_AC = 128;
    const int total = NU_BL + NU_AL + NU_BC + NU_AC;
    BgCvt bgc = bg_make(p, (int)blockIdx.x - (int)((blockIdx.x >> 3) & 3) * 9 * (int)gridDim.x, bg_s1(), (int)gridDim.x);
    const int G_ = (int)gridDim.x;
    const int vcu_ = (G_ % 8 == 0) ? (int)((blockIdx.x % 8) * (G_ / 8) + blockIdx.x / 8) : (int)blockIdx.x;
    for (int u = vcu_; u < total; u += G_) {
        if (u < NU_BL || (u >= NU_BL + NU_AL && u < NU_BL + NU_AL + NU_BC)) {
            const bool isctx = u >= NU_BL;
            const int uu = isctx ? u - (NU_BL + NU_AL) : u;
            int b, h, qt;
            if (!isctx) { b = uu >> 6; h = (uu >> 4) & 3; qt = uu & 15; } else { b = uu >> 3; h = (uu >> 1) & 3; qt = uu & 1; }
            const int qn = (isctx ? 0 : CTXL) + qt * 128 + wave * 16 + (lane & 15);
            const int qcol[2] = {768 + h * 128, 768 + h * 128 + 64};
            const int kcol[2] = {1280 + h * 128, 1280 + h * 128 + 64};
            const int vcol = 1792 + h * 128;
            f32x4 O[2][8]; float ls[2], mr[2];
            const int ntiles = isctx ? 4 : 36;
            attn_unit<true>(p, lds, bgc, hp, b, ntiles, ntiles, 0, false, qn, qcol, kcol, vcol, O, ls, mr);
            const float il0 = 1.f / ls[0], il1 = lam / ls[1];
            float ss = 0.f;
#pragma unroll
            for (int dt = 0; dt < 8; ++dt)
#pragma unroll
                for (int i = 0; i < 4; ++i) { const float a = O[0][dt][i] * il0 - O[1][dt][i] * il1; O[0][dt][i] = a; ss += a * a; }
            ss += __shfl_xor(ss, 16); ss += __shfl_xor(ss, 32);
            const float rn = rsqrtf(ss * (1.f / 128.f) + 1e-5f) * 0.8f;
            const float* sg = p.in[12];
            u16* orow = ao + (size_t)(b * NTOK + qn) * D + 512 + h * 128;
#pragma unroll
            for (int dt = 0; dt < 8; ++dt) {
                const int dv = dt * 16 + g * 4;
                u32x2 o;
                o[0] = pack2(O[0][dt][0] * rn * sg[dv], O[0][dt][1] * rn * sg[dv + 1]);
                o[1] = pack2(O[0][dt][2] * rn * sg[dv + 2], O[0][dt][3] * rn * sg[dv + 3]);
                *(u32x2*)(orow + dv) = o;
            }
        } else {
            const bool isctx = u >= NU_BL + NU_AL + NU_BC;
            const int uu = isctx ? u - (NU_BL + NU_AL + NU_BC) : u - NU_BL;
            int b, kvh, pb;
            if (!isctx) { b = uu >> 7; kvh = (uu >> 6) & 1; pb = uu & 63; } else { b = uu >> 4; kvh = (uu >> 3) & 1; pb = uu & 7; }
            const int gh = wave & 3, head = kvh * 4 + gh;
            const int pos = pb * 32 + (wave >> 2) * 16 + (lane & 15);
            const int qn = (isctx ? 0 : CTXL) + pos;
            int ntiles = 4, win_n0 = 0;
            if (!isctx) {
                int lo = pb * 32 - 128; if (lo < 0) lo = 0; lo &= ~63;
                int hi = pb * 32 + 160; if (hi > SEQ) hi = SEQ;
                ntiles = 4 + (hi - lo + 63) / 64; win_n0 = CTXL + lo;
            }
            const int qcol[1] = {head * 64}; const int kcol[1] = {512 + kvh * 64}; const int vcol = 640 + kvh * 64;
            f32x4 O[1][4]; float ls[1], mr[1];
            attn_unit<false>(p, lds, bgc, hp, b, ntiles, 4, win_n0, !isctx, qn, qcol, kcol, vcol, O, ls, mr);
            const float sink = p.in[10][kvh * 4 + gh];
            const float l = ls[0] + __builtin_amdgcn_exp2f(sink * L2E - mr[0]);
            const float il = 1.f / l;
            u16* orow = ao + (size_t)(b * NTOK + qn) * D + head * 64;
#pragma unroll
            for (int dt = 0; dt < 4; ++dt) {
                const int dv = dt * 16 + g * 4;
                u32x2 o; o[0] = pack2(O[0][dt][0] * il, O[0][dt][1] * il); o[1] = pack2(O[0][dt][2] * il, O[0][dt][3] * il);
                *(u32x2*)(orow + dv) = o;
            }
        }
    }
    bg_finish(p, bgc);
}

DI int tok_row(int t, bool lat_only) { return lat_only ? ((t >> 11) * NTOK + CTXL + (t & 2047)) : t; }

DI void phase_topk(const Params& p, int layer, int ntok, ldsp lds) {
    constexpr int TPBMAX = 80, SSTR = 260;
    LAS float* scl = (LAS float*)(lds + LDS_BASE);
    LAS float* biasl = scl + TPBMAX * SSTR;
    LAS float* gscl = biasl + 256;
    LAS float* lval = gscl + TPBMAX * 8;
    LAS float* lsv = lval + TPBMAX * 32;
    LAS int* lidx = (LAS int*)(lsv + TPBMAX * 32);
    const int tid = threadIdx.x, tok = tid >> 2, q = tid & 3;
    const float* sc = (const float*)(p.ws + WS_SC);
    const float* bias = p.in[29] + layer * 256;
    int* eidx = (int*)(p.ws + WS_EIDX); float* gw = (float*)(p.ws + WS_GW); int* epos = (int*)(p.ws + WS_EPOS);
    int* cnt = (int*)(p.ws + CTL_CNT) + layer * 256 * CNT_STR;
    const int G = gridDim.x;
    int TPB = (ntok + G - 1) / G; TPB = TPB > TPBMAX ? TPBMAX : TPB;
    for (int base = blockIdx.x * TPB; base < ntok; base += G * TPB) {
        const int n = (ntok - base) < TPB ? (ntok - base) : TPB;
        __syncthreads();
        if (tid < 64) *(LAS f32x4*)(biasl + tid * 4) = *(const f32x4*)(bias + tid * 4);
        for (int i = tid; i < n * 64; i += NTHR) { const int tk_ = i >> 6, c4 = i & 63; *(LAS f32x4*)(scl + tk_ * SSTR + c4 * 4) = *(const f32x4*)(sc + (size_t)(base + tk_) * 256 + c4 * 4); }
        __syncthreads();
        const bool act = tok < n;
        const int tk = act ? tok : n - 1;
        {
#pragma unroll
            for (int h = 0; h < 2; ++h) {
                const int g = 2 * q + h; float m1 = -3e38f, m2 = -3e38f;
#pragma unroll
                for (int j = 0; j < 8; ++j) {
                    const f32x4 s4 = *(const LAS f32x4*)(scl + tk * SSTR + g * 32 + j * 4), b4 = *(const LAS f32x4*)(biasl + g * 32 + j * 4);
#pragma unroll
                    for (int e = 0; e < 4; ++e) { const float v = s4[e] + b4[e]; const float t = fminf(m1, v); m1 = fmaxf(m1, v); m2 = fmaxf(m2, t); }
                }
                gscl[tk * 8 + g] = m1 + m2;
            }
        }
        __syncthreads();
        int gq = 0;
        {
            const f32x4 ga = *(const LAS f32x4*)(gscl + tk * 8), gb = *(const LAS f32x4*)(gscl + tk * 8 + 4);
            const float gsc[8] = {ga[0], ga[1], ga[2], ga[3], gb[0], gb[1], gb[2], gb[3]};
            int c = 0;
#pragma unroll
            for (int g = 0; g < 8; ++g) {
                int rank = 0;
#pragma unroll
                for (int g2 = 0; g2 < 8; ++g2) rank += ((gsc[g2] > gsc[g]) || (gsc[g2] == gsc[g] && g2 < g)) ? 1 : 0;
                const bool sel = rank < 4;
                gq = (sel && c == q) ? g : gq; c += sel ? 1 : 0;
            }
        }
        {
            float val[8], sv[8]; int idx[8];
#pragma unroll
            for (int k = 0; k < 8; ++k) { val[k] = -3e38f; sv[k] = 0.f; idx[k] = 0; }
#pragma unroll 1
            for (int j = 0; j < 8; ++j) {
                const f32x4 s4 = *(const LAS f32x4*)(scl + tk * SSTR + gq * 32 + j * 4), b4 = *(const LAS f32x4*)(biasl + gq * 32 + j * 4);
#pragma unroll
                for (int e = 0; e < 4; ++e) {
                    const float x = s4[e] + b4[e], sx = s4[e]; const int ix = gq * 32 + j * 4 + e;
                    bool c[8];
#pragma unroll
                    for (int k = 0; k < 8; ++k) c[k] = x > val[k];
#pragma unroll
                    for (int k = 7; k >= 1; --k) {
                        val[k] = c[k] ? (c[k - 1] ? val[k - 1] : x) : val[k];
                        sv[k] = c[k] ? (c[k - 1] ? sv[k - 1] : sx) : sv[k];
                        idx[k] = c[k] ? (c[k - 1] ? idx[k - 1] : ix) : idx[k];
                    }
                    val[0] = c[0] ? x : val[0]; sv[0] = c[0] ? sx : sv[0]; idx[0] = c[0] ? ix : idx[0];
                }
            }
            const int lb = (tk * 4 + q) * 8;
            *(LAS f32x4*)(lval + lb) = (f32x4){val[0], val[1], val[2], val[3]}; *(LAS f32x4*)(lval + lb + 4) = (f32x4){val[4], val[5], val[6], val[7]};
            *(LAS f32x4*)(lsv + lb) = (f32x4){sv[0], sv[1], sv[2], sv[3]}; *(LAS f32x4*)(lsv + lb + 4) = (f32x4){sv[4], sv[5], sv[6], sv[7]};
            *(LAS i32x4*)(lidx + lb) = (i32x4){idx[0], idx[1], idx[2], idx[3]}; *(LAS i32x4*)(lidx + lb + 4) = (i32x4){idx[4], idx[5], idx[6], idx[7]};
        }
        __syncthreads();
        if (act && q == 0) {
            int h0 = 0, h1 = 0, h2 = 0, h3 = 0; float ms[8]; int me[8]; float ssum = 0.f;
            const int lb = tk * 32;
#pragma unroll
            for (int k = 0; k < 8; ++k) {
                const float v0 = lval[lb + h0], v1 = lval[lb + 8 + h1], v2 = lval[lb + 16 + h2], v3 = lval[lb + 24 + h3];
                int best = 0; float bv = v0;
                if (v1 > bv) { bv = v1; best = 1; }
                if (v2 > bv) { bv = v2; best = 2; }
                if (v3 > bv) { bv = v3; best = 3; }
                const int hb = best == 0 ? h0 : best == 1 ? h1 : best == 2 ? h2 : h3;
                const int li = lb + best * 8 + hb;
                ms[k] = lsv[li]; me[k] = lidx[li]; ssum += ms[k];
                h0 += best == 0 ? 1 : 0; h1 += best == 1 ? 1 : 0; h2 += best == 2 ? 1 : 0; h3 += best == 3 ? 1 : 0;
            }
            const size_t t = (size_t)(base + tk);
            int pos[8]; float w[8];
#pragma unroll
            for (int k = 0; k < 8; ++k) { pos[k] = atomicAdd(&cnt[me[k] * CNT_STR], 1); w[k] = ms[k] / ssum * 2.5f; }
            *(i32x4*)(eidx + t * 8) = (i32x4){me[0], me[1], me[2], me[3]}; *(i32x4*)(eidx + t * 8 + 4) = (i32x4){me[4], me[5], me[6], me[7]};
            *(f32x4*)(gw + t * 8) = (f32x4){w[0], w[1], w[2], w[3]}; *(f32x4*)(gw + t * 8 + 4) = (f32x4){w[4], w[5], w[6], w[7]};
            *(i32x4*)(epos + t * 8) = (i32x4){pos[0], pos[1], pos[2], pos[3]}; *(i32x4*)(epos + t * 8 + 4) = (i32x4){pos[4], pos[5], pos[6], pos[7]};
        }
    }
}

DI void moe_prefix(const Params& p, int layer, ldsp lds) {
    LAS int* cntl = (LAS int*)(lds + LDS_MISC); LAS int* rs = cntl + 256; LAS int* ts = rs + 260;
    const int* cnt = (const int*)(p.ws + CTL_CNT) + layer * 256 * CNT_STR;
    const int tid = threadIdx.x;
    __syncthreads();
    if (tid < 256) cntl[tid] = cnt[tid * CNT_STR];
    __syncthreads();
    if (tid <= 256) {
        int a = 0, b = 0;
        for (int e = 0; e < tid; ++e) { const int c = cntl[e]; a += c; b += (c + 127) >> 7; }
        rs[tid] = a; ts[tid] = b;
    }
    __syncthreads();
}

DI void phase_fill(const Params& p, int layer, int ntok, ldsp lds) {
    moe_prefix(p, layer, lds);
    LAS int* rs = (LAS int*)(lds + LDS_MISC) + 256;
    const int* eidx = (const int*)(p.ws + WS_EIDX); const float* gw = (const float*)(p.ws + WS_GW); const int* epos = (const int*)(p.ws + WS_EPOS);
    int* rtok = (int*)(p.ws + WS_RTOK); float* rw = (float*)(p.ws + WS_RW);
    for (int i = blockIdx.x * NTHR + threadIdx.x; i < ntok * 8; i += gridDim.x * NTHR) {
        const int e = eidx[i]; const int dest = rs[e] + epos[i];
        rtok[dest] = i; rw[dest] = gw[i];
    }
}

struct ALoadGather {
    const u16* ubuf; const LAS int* tokrow;
    DI u32x4 operator()(int r, int k) const {
        int tr = tokrow[r]; tr = tr < 0 ? 0 : tr;
        return *(const u32x4*)(ubuf + (size_t)tr * D + k);
    }
};
struct BLoadGU {
    const float* W; int hf;
    DI f32x4 operator()(int k, int c) const {
        const int wc = c >> 6, w = c & 63;
        const int gcol = (w < 32) ? (hf * 128 + wc * 32 + w) : (256 + hf * 128 + wc * 32 + (w - 32));
        return *(const f32x4*)(W + (size_t)k * 512 + gcol);
    }
};

struct BLoad16GU {
    const u16* W; int hf;
    DI u32x4 operator()(int k, int c) const {
        const int wc = c >> 6, w = c & 63;
        const int gcol = (w < 32) ? (hf * 128 + wc * 32 + w) : (256 + hf * 128 + wc * 32 + (w - 32));
        return *(const u32x4*)(W + (size_t)k * 512 + gcol);
    }
};
DI void phase_experts(const Params& p, int layer, int ntok, bool lat_only, ldsp lds, u16* slotb, u16* shb) {
    moe_prefix(p, layer, lds);
    LAS int* cntl = (LAS int*)(lds + LDS_MISC); LAS int* rs = cntl + 256; LAS int* ts = rs + 260;
    LAS int* tokrow = ts + 260; LAS float* wrow = (LAS float*)(tokrow + 128); LAS int* orow = (LAS int*)(wrow + 128);
    const int tid = threadIdx.x, lane = tid & 63, wave = tid >> 6, wr = wave >> 2, wc = wave & 3, g = lane >> 4;
    const int* rtok = (const int*)(p.ws + WS_RTOK); const float* rw = (const float*)(p.ws + WS_RW);
    const u16* ubuf = (const u16*)(p.ws + WS_U);
    ldsp Hs = lds + LDS_HS;
    const int nrt = ts[256], nsh = ntok >> 7, total = nrt + nsh;
    const int vcu = (gridDim.x % 8 == 0) ? (int)((blockIdx.x % 8) * (gridDim.x / 8) + blockIdx.x / 8) : (int)blockIdx.x;
    for (int u = vcu; u < total; u += gridDim.x) {
        int e, r0, nrows;
        if (u < nrt) {
            int lo = 0, hi = 255;
            while (lo < hi) { const int mid = (lo + hi + 1) >> 1; if (ts[mid] <= u) lo = mid; else hi = mid - 1; }
            e = lo; const int j = u - ts[e]; r0 = rs[e] + j * 128; nrows = cntl[e] - j * 128; if (nrows > 128) nrows = 128;
        } else { e = 256; r0 = (u - nrt) * 128; nrows = 128; }
        __syncthreads();
        if (tid < 128) {
            if (e < 256) {
                if (tid < nrows) { const int fi = rtok[r0 + tid]; tokrow[tid] = tok_row(fi >> 3, lat_only); orow[tid] = fi; wrow[tid] = rw[r0 + tid]; }
                else { tokrow[tid] = -1; orow[tid] = 0; wrow[tid] = 0.f; }
            } else { tokrow[tid] = tok_row(r0 + tid, lat_only); orow[tid] = r0 + tid; wrow[tid] = 1.f; }
        }
        __syncthreads();
        const u16* W1 = (e < 256) ? (const u16*)(p.ws + WB_EIN) + ((size_t)layer * 256 + e) * 1024 * 512 : (const u16*)(p.ws + WB_SIN) + (size_t)layer * 1024 * 512;
        const u16* W2 = (e < 256) ? (const u16*)(p.ws + WB_EOUT) + ((size_t)layer * 256 + e) * 256 * 1024 : (const u16*)(p.ws + WB_SOUT) + (size_t)layer * 256 * 1024;
#pragma unroll 1
        for (int hf = 0; hf < 2; ++hf) {
            f32x4 acc[4][4];
#pragma unroll
            for (int i = 0; i < 4; ++i)
#pragma unroll
                for (int j = 0; j < 4; ++j) acc[i][j] = (f32x4){0.f, 0.f, 0.f, 0.f};
            ALoadGather al{ubuf, tokrow}; BLoad16GU bl{W1, hf};
            gemm_kloop16<true, A_STR>(lds, 16, al, bl, acc, (const LAS unsigned char*)nullptr);
#pragma unroll
            for (int mt = 0; mt < 4; ++mt)
#pragma unroll
                for (int nt = 0; nt < 2; ++nt)
#pragma unroll
                    for (int i = 0; i < 4; ++i) {
                        const int row = wr * 64 + mt * 16 + g * 4 + i, col = hf * 128 + wc * 32 + nt * 16 + (lane & 15);
                        const float hv = siluf_(acc[mt][nt][i]) * acc[mt][nt + 2][i];
                        *(LAS u16*)(Hs + row * B_STR + col * 2) = f2bf(hv);
                    }
        }
#pragma unroll 1
        for (int cq = 0; cq < 4; ++cq) {
            f32x4 acc[4][4];
#pragma unroll
            for (int i = 0; i < 4; ++i)
#pragma unroll
                for (int j = 0; j < 4; ++j) acc[i][j] = (f32x4){0.f, 0.f, 0.f, 0.f};
            ALoadNone al; BLoad16U bl{W2 + cq * 256, 1024};
            gemm_kloop16<false, B_STR>(lds, 4, al, bl, acc, Hs);
            ldsp wbuf = (wave < 4) ? (lds + LDS_AS + wave * 4608) : (lds + LDS_MISC + 8192 + (wave - 4) * 4608);
            u16* obase = ((e < 256) ? slotb : shb) + cq * 256 + wc * 64;
#pragma unroll
            for (int mp = 0; mp < 2; ++mp) {
#pragma unroll
                for (int m2 = 0; m2 < 2; ++m2)
#pragma unroll
                    for (int i = 0; i < 4; ++i) {
                        const int mt = mp * 2 + m2;
                        const float w = wrow[wr * 64 + mt * 16 + g * 4 + i];
#pragma unroll
                        for (int nt = 0; nt < 4; ++nt)
                            *(LAS u16*)(wbuf + (m2 * 16 + g * 4 + i) * 144 + (nt * 16 + (lane & 15)) * 2) = f2bf(acc[mt][nt][i] * w);
                    }
#pragma unroll
                for (int q = 0; q < 4; ++q) {
                    const int id = lane + 64 * q, rl = id >> 3, ch = id & 7;
                    const u32x4 v = *(const LAS u32x4*)(wbuf + rl * 144 + ch * 16);
                    const int row = wr * 64 + mp * 32 + rl;
                    if (tokrow[row] >= 0) *(u32x4*)(obase + (size_t)orow[row] * D + ch * 8) = v;
                }
            }
        }
    }
}


constexpr int LDS_X4 = LDS_BASE + 8 * 128 * 64 * 2;
DI void moe_prefix256(const Params& p, int layer, ldsp lds) {
    LAS int* cntl = (LAS int*)(lds + LDS_X4); LAS int* pt = cntl + 256; LAS int* wtot = pt + 260;
    const int* cnt = (const int*)(p.ws + CTL_CNT) + layer * 256 * CNT_STR;
    const int tid = threadIdx.x, lane = tid & 63, wave = tid >> 6;
    __syncthreads();
    int incl = 0;
    if (tid < 256) {
        const int c = cnt[tid * CNT_STR]; cntl[tid] = c; incl = (c + 255) >> 8;
#pragma unroll
        for (int o = 1; o <= 32; o <<= 1) { const int t = __shfl_up(incl, o); incl += (lane >= o) ? t : 0; }
        if (lane == 63) wtot[wave] = incl;
    }
    __syncthreads();
    if (tid < 256) {
        int off = 0;
#pragma unroll
        for (int w = 0; w < 3; ++w) off += (w < wave) ? wtot[w] : 0;
        pt[tid + 1] = off + incl;
        if (tid == 0) pt[0] = 0;
    }
    __syncthreads();
}
DI void phase_fill4(const Params& p, int layer, int ntok, bool lat_only, ldsp lds) {
    moe_prefix256(p, layer, lds);
    LAS int* cntl = (LAS int*)(lds + LDS_X4); LAS int* pt = cntl + 256;
    const int* eidx = (const int*)(p.ws + WS_EIDX); const float* gw = (const float*)(p.ws + WS_GW); const int* epos = (const int*)(p.ws + WS_EPOS);
    int* arow = (int*)(p.ws + WS_AROW); int* rtk = (int*)(p.ws + WS_RTK2); float* rw = (float*)(p.ws + WS_RW2);
    for (int i = blockIdx.x * NTHR + threadIdx.x; i < ntok * 8; i += gridDim.x * NTHR) {
        const int e = eidx[i]; const int dest = pt[e] * 256 + epos[i];
        arow[dest] = tok_row(i >> 3, lat_only); rtk[dest] = i; rw[dest] = gw[i];
    }
    for (int i = blockIdx.x * NTHR + threadIdx.x; i < 256 * 256; i += gridDim.x * NTHR) {
        const int e = i >> 8, j = i & 255; const int c = cntl[e]; const int pc = ((c + 255) >> 8) << 8;
        if (c + j < pc) { const int d = pt[e] * 256 + c + j; arow[d] = 0; rtk[d] = -1; rw[d] = 0.f; }
    }
}
DI void phase_experts4_g1(const Params& p, int layer, int ntok, bool lat_only, ldsp lds) {
    moe_prefix256(p, layer, lds);
    const LAS int* pt = (const LAS int*)(lds + LDS_X4) + 256;
    const int NT = pt[256], G = gridDim.x;
    const int vcu = (G % 8 == 0) ? (int)((blockIdx.x % 8) * (G / 8) + blockIdx.x / 8) : (int)blockIdx.x;
    pg8::ExpSched S{pt, NT, ntok >> 8, 2, G, vcu};
    pg8::AddrExp1 AD{(const u16*)(p.ws + WS_U), (const int*)(p.ws + WS_AROW), (const u16*)(p.ws + WT_IN) + (size_t)layer * 257 * 512 * 1024, NT, lat_only};
    pg8::gemm_phase_gather(lds + LDS_BASE, 1024, S, AD, pg8::EpiExpH{(u16*)(p.ws + WS_HG), NT});
}
DI void phase_experts4_g2(const Params& p, int layer, int ntok, ldsp lds, u16* slotb, u16* shb) {
    moe_prefix256(p, layer, lds);
    const LAS int* pt = (const LAS int*)(lds + LDS_X4) + 256;
    const int NT = pt[256], G = gridDim.x;
    const int vcu = (G % 8 == 0) ? (int)((blockIdx.x % 8) * (G / 8) + blockIdx.x / 8) : (int)blockIdx.x;
    pg8::ExpSched S{pt, NT, ntok >> 8, 4, G, vcu};
    pg8::AddrExp2 AD{(const u16*)(p.ws + WS_HG), (const u16*)(p.ws + WT_OUT) + (size_t)layer * 257 * 1024 * 256, NT};
    pg8::gemm_phase_st(lds + LDS_BASE, 256, S, AD, pg8::EpiExpOut{slotb, (long)(shb - slotb), (const int*)(p.ws + WS_RTK2), (const float*)(p.ws + WS_RW2), NT, (LAS u32x2*)(lds + LDS_X4 + 4096)});
}

DI void phase_mix(const Params& p) {
    const int lane = threadIdx.x & 63, wave = threadIdx.x >> 6;
    const float* zb = (const float*)(p.ws + WS_Z); u16* xm = (u16*)(p.ws + WS_XMIX); const float* mu = p.in[13];
    for (int row = blockIdx.x * 8 + wave; row < T; row += gridDim.x * 8) {
        const int n = row % NTOK;
        const bool hasp = !(n == 0 || n == CTXL), hasn = !(n == CTXL - 1 || n == NTOK - 1);
#pragma unroll
        for (int j = 0; j < 4; ++j) {
            const int col = lane * 4 + 256 * j;
            const f32x4 uc = *(const f32x4*)(zb + (size_t)row * D + col);
            f32x4 up = {0.f, 0.f, 0.f, 0.f}, un = {0.f, 0.f, 0.f, 0.f};
            if (hasp) up = *(const f32x4*)(zb + (size_t)(row - 1) * D + col);
            if (hasn) un = *(const f32x4*)(zb + (size_t)(row + 1) * D + col);
            const f32x4 dx = 0.5f * (up + un) - uc;
#pragma unroll
            for (int m = 0; m < 6; ++m) {
                const f32x4 x = uc + dx * *(const f32x4*)(mu + m * D + col);
                u32x2 o; o[0] = pack2(x[0], x[1]); o[1] = pack2(x[2], x[3]);
                *(u32x2*)(xm + ((size_t)m * T + row) * D + col) = o;
            }
        }
    }
}

constexpr int SM_STR = 144;
constexpr int SM_SZ = 64 * SM_STR;
DI s16x8 frag_row(const LAS unsigned char* P, int r0, int c0, int lane) {
    return *(const LAS s16x8*)(P + (r0 + (lane & 15)) * SM_STR + (c0 + 8 * (lane >> 4)) * 2);
}
DI s16x8 frag_tr(const LAS unsigned char* P, int r0, int c0, int lane) {
    const LAS unsigned char* a = P + (r0 + 8 * (lane >> 4) + ((lane >> 2) & 3)) * SM_STR + (c0 + 4 * (lane & 3)) * 2;
    const s16x4 lo = vtr(a), hi = vtr(a + 4 * SM_STR);
    return (s16x8){lo[0], lo[1], lo[2], lo[3], hi[0], hi[1], hi[2], hi[3]};
}
template <bool AT, bool BN>
DI void mm64(f32x4 (&acc)[2], const LAS unsigned char* X, const LAS unsigned char* Y, int mt, int nt0, int lane) {
#pragma unroll
    for (int ks = 0; ks < 2; ++ks) {
        const s16x8 a = AT ? frag_tr(X, ks * 32, mt * 16, lane) : frag_row(X, mt * 16, ks * 32, lane);
#pragma unroll
        for (int n = 0; n < 2; ++n) {
            const s16x8 b = BN ? frag_tr(Y, ks * 32, (nt0 + n) * 16, lane) : frag_row(Y, (nt0 + n) * 16, ks * 32, lane);
            acc[n] = __builtin_amdgcn_mfma_f32_16x16x32_bf16(a, b, acc[n], 0, 0, 0);
        }
    }
}
DI void st_tile(LAS unsigned char* P, const f32x4& v, int mt, int nt, int lane) {
#pragma unroll
    for (int i = 0; i < 4; ++i) *(LAS u16*)(P + (mt * 16 + 4 * (lane >> 4) + i) * SM_STR + (nt * 16 + (lane & 15)) * 2) = f2bf(v[i]);
}
#define ZERO2(a) do { a[0] = (f32x4){0.f, 0.f, 0.f, 0.f}; a[1] = (f32x4){0.f, 0.f, 0.f, 0.f}; } while (0)

DI void phase_scan(const Params& p, ldsp lds) {
    const int tid = threadIdx.x, lane = tid & 63, wave = tid >> 6, g = lane >> 4;
    const int mt = wave >> 1, nt0 = (wave & 1) * 2;
    const int tt = tid >> 3, c8 = tid & 7;
    ldsp base = lds + LDS_BASE;
#define SL(i) (base + (i) * SM_SZ)
    LAS float* CS = (LAS float*)SL(5);
    LAS float* gc = (LAS float*)(base + 16 * SM_SZ);
    const u16* rb = (const u16*)(p.ws + WS_R); const u16* kb = (const u16*)(p.ws + WS_K); const u16* vb = (const u16*)(p.ws + WS_V);
    for (int u = blockIdx.x; u < 256; u += gridDim.x) {
        const int b = u >> 5, h = (u >> 1) & 15, dir = u & 1;
        const u16* ab = (const u16*)(p.ws + WS_A0) + (size_t)dir * T * D;
        const float* lwb = (const float*)(p.ws + WS_W0) + (size_t)dir * T * D;
        float* yb = (float*)(p.ws + WS_Y) + (size_t)dir * TL * D;
        const int cofs = h * 64 + c8 * 8;
        const f32x4 kkw0 = *(const f32x4*)(p.in[24] + cofs), kkw1 = *(const f32x4*)(p.in[24] + cofs + 4);
        const f32x4 kaw0 = *(const f32x4*)(p.in[25] + cofs), kaw1 = *(const f32x4*)(p.in[25] + cofs + 4);
        __syncthreads();
        *(LAS u32x4*)(SL(14) + tt * SM_STR + c8 * 16) = (u32x4){0, 0, 0, 0};
        *(LAS u32x4*)(SL(15) + tt * SM_STR + c8 * 16) = (u32x4){0, 0, 0, 0};
        u32x4 pr, pk, pv, pa; f32x4 pw0, pw1;
#define SCAN_N(s) ((dir == 0) ? (s) : ((s) < CTXL ? (CTXL - 1 - (s)) : (NTOK + CTXL - 1 - (s))))
#define LOADC(c) { const size_t o_ = (size_t)(b * NTOK + SCAN_N((c) * 64 + tt)) * D + cofs; \
            pr = *(const u32x4*)(rb + o_); pk = *(const u32x4*)(kb + o_); pv = *(const u32x4*)(vb + o_); pa = *(const u32x4*)(ab + o_); \
            pw0 = *(const f32x4*)(lwb + o_); pw1 = *(const f32x4*)(lwb + o_ + 4); }
        LOADC(0);
        for (int c = 0; c < NTOK / 64; ++c) {
            const u32x4 cr = pr, ck = pk, cv = pv, ca = pa; const f32x4 cw0 = pw0, cw1 = pw1;
            __syncthreads();
            *(LAS f32x4*)(CS + tt * 64 + c8 * 8) = cw0; *(LAS f32x4*)(CS + tt * 64 + c8 * 8 + 4) = cw1;
            __syncthreads();
            {
                LAS float* TOT = gc + 64;
                const int col_ = tid & 63, seg_ = tid >> 6;
                float v_[8];
#pragma unroll
                for (int i = 0; i < 8; ++i) v_[i] = CS[(seg_ * 8 + i) * 64 + col_];
#pragma unroll
                for (int i = 1; i < 8; ++i) v_[i] += v_[i - 1];
                TOT[seg_ * 64 + col_] = v_[7];
                __syncthreads();
                float off_ = 0.f;
#pragma unroll
                for (int s2 = 0; s2 < 7; ++s2) { const float t_ = TOT[s2 * 64 + col_]; off_ += (s2 < seg_) ? t_ : 0.f; }
#pragma unroll
                for (int i = 0; i < 8; ++i) CS[(seg_ * 8 + i) * 64 + col_] = v_[i] + off_;
            }
            __syncthreads();
            {
                const f32x4 cc0 = *(const LAS f32x4*)(CS + tt * 64 + c8 * 8), cc1 = *(const LAS f32x4*)(CS + tt * 64 + c8 * 8 + 4);
                float cs[8], lwv[8], rr[8], kh[8], as[8];
#pragma unroll
                for (int j = 0; j < 4; ++j) { cs[j] = cc0[j]; cs[4 + j] = cc1[j]; lwv[j] = cw0[j]; lwv[4 + j] = cw1[j]; }
#pragma unroll
                for (int j = 0; j < 4; ++j) {
                    rr[2 * j] = bf2f((u16)(cr[j] & 0xffffu)); rr[2 * j + 1] = bf2f((u16)(cr[j] >> 16));
                    kh[2 * j] = bf2f((u16)(ck[j] & 0xffffu)); kh[2 * j + 1] = bf2f((u16)(ck[j] >> 16));
                    as[2 * j] = bf2f((u16)(ca[j] & 0xffffu)); as[2 * j + 1] = bf2f((u16)(ca[j] >> 16));
                }
                float kr[8]; float ss = 0.f;
#pragma unroll
                for (int j = 0; j < 8; ++j) { kr[j] = kh[j] * (j < 4 ? kkw0[j] : kkw1[j - 4]); ss += kr[j] * kr[j]; }
                ss += __shfl_xor(ss, 1); ss += __shfl_xor(ss, 2); ss += __shfl_xor(ss, 4);
                const float rn = rsqrtf(fmaxf(ss, 1e-24f));
                float at[8], bt[8], kt[8], rt[8];
#pragma unroll
                for (int j = 0; j < 8; ++j) {
                    const float kkv = kr[j] * rn;
                    const float e1 = __expf(cs[j] - lwv[j]), e2 = __expf(-cs[j]), e3 = __expf(cs[j]);
                    const float kaj = (j < 4 ? kaw0[j] : kaw1[j - 4]);
                    at[j] = -kkv * e1; bt[j] = kkv * as[j] * e2; kt[j] = kh[j] * (1.f + (as[j] - 1.f) * kaj) * e2; rt[j] = rr[j] * e3;
                    if (tt == 63) gc[c8 * 8 + j] = e3;
                }
                const int off = tt * SM_STR + c8 * 16;
                *(LAS u32x4*)(SL(0) + off) = (u32x4){pack2(at[0], at[1]), pack2(at[2], at[3]), pack2(at[4], at[5]), pack2(at[6], at[7])};
                *(LAS u32x4*)(SL(1) + off) = (u32x4){pack2(bt[0], bt[1]), pack2(bt[2], bt[3]), pack2(bt[4], bt[5]), pack2(bt[6], bt[7])};
                *(LAS u32x4*)(SL(2) + off) = (u32x4){pack2(kt[0], kt[1]), pack2(kt[2], kt[3]), pack2(kt[4], kt[5]), pack2(kt[6], kt[7])};
                *(LAS u32x4*)(SL(3) + off) = (u32x4){pack2(rt[0], rt[1]), pack2(rt[2], rt[3]), pack2(rt[4], rt[5]), pack2(rt[6], rt[7])};
                *(LAS u32x4*)(SL(4) + off) = cv;
            }
            { const int cn_ = (c + 1 < NTOK / 64) ? c + 1 : c; LOADC(cn_); }
            __syncthreads();
            f32x4 acc[2], Tacc[2], P2acc[2], AVacc[2];
            ZERO2(acc); mm64<false, false>(acc, SL(0), SL(1), mt, nt0, lane);
#pragma unroll
            for (int n = 0; n < 2; ++n) {
                const int nt = nt0 + n;
                const bool isD = (mt == nt), isO1 = ((mt >> 1) == (nt >> 1)) && (mt != nt), isO2 = ((mt >> 1) != (nt >> 1));
                f32x4 dv, o1v, o2v;
#pragma unroll
                for (int i = 0; i < 4; ++i) {
                    const int row = mt * 16 + 4 * g + i, col = nt * 16 + (lane & 15);
                    const float v = (col < row) ? acc[n][i] : 0.f;
                    dv[i] = isD ? v : 0.f; o1v[i] = isO1 ? v : 0.f; o2v[i] = isO2 ? v : 0.f;
                    Tacc[n][i] = dv[i] + (row == col ? 1.f : 0.f);
                }
                st_tile(SL(5), dv, mt, nt, lane); st_tile(SL(12), o1v, mt, nt, lane); st_tile(SL(13), o2v, mt, nt, lane);
                st_tile(SL(10), Tacc[n], mt, nt, lane);
            }
            ZERO2(acc); mm64<false, false>(acc, SL(0), SL(2), mt, nt0, lane);
#pragma unroll
            for (int n = 0; n < 2; ++n)
#pragma unroll
                for (int i = 0; i < 4; ++i) { const int row = mt * 16 + 4 * g + i, col = (nt0 + n) * 16 + (lane & 15); if (!(col < row)) acc[n][i] = 0.f; }
            st_tile(SL(7), acc[0], mt, nt0, lane); st_tile(SL(7), acc[1], mt, nt0 + 1, lane);
            ZERO2(acc); mm64<false, false>(acc, SL(3), SL(1), mt, nt0, lane);
#pragma unroll
            for (int n = 0; n < 2; ++n)
#pragma unroll
                for (int i = 0; i < 4; ++i) { const int row = mt * 16 + 4 * g + i, col = (nt0 + n) * 16 + (lane & 15); if (!(col <= row)) acc[n][i] = 0.f; }
            st_tile(SL(8), acc[0], mt, nt0, lane); st_tile(SL(8), acc[1], mt, nt0 + 1, lane);
            ZERO2(acc); mm64<false, false>(acc, SL(3), SL(2), mt, nt0, lane);
#pragma unroll
            for (int n = 0; n < 2; ++n)
#pragma unroll
                for (int i = 0; i < 4; ++i) { const int row = mt * 16 + 4 * g + i, col = (nt0 + n) * 16 + (lane & 15); if (!(col <= row)) acc[n][i] = 0.f; }
            st_tile(SL(9), acc[0], mt, nt0, lane); st_tile(SL(9), acc[1], mt, nt0 + 1, lane);
            ZERO2(P2acc); mm64<true, true>(P2acc, SL(2), SL(4), mt, nt0, lane);
            __syncthreads();
            ZERO2(acc); mm64<false, true>(acc, SL(5), SL(5), mt, nt0, lane);
            st_tile(SL(6), acc[0], mt, nt0, lane); st_tile(SL(6), acc[1], mt, nt0 + 1, lane);
            ZERO2(acc); mm64<false, true>(acc, SL(7), SL(4), mt, nt0, lane);
            st_tile(SL(11), acc[0], mt, nt0, lane); st_tile(SL(11), acc[1], mt, nt0 + 1, lane);
            ZERO2(AVacc); mm64<false, true>(AVacc, SL(9), SL(4), mt, nt0, lane);
            __syncthreads();
            mm64<false, true>(Tacc, SL(10), SL(6), mt, nt0, lane);
            st_tile(SL(2), Tacc[0], mt, nt0, lane); st_tile(SL(2), Tacc[1], mt, nt0 + 1, lane);
            ZERO2(acc); mm64<false, true>(acc, SL(6), SL(6), mt, nt0, lane);
            st_tile(SL(5), acc[0], mt, nt0, lane); st_tile(SL(5), acc[1], mt, nt0 + 1, lane);
            __syncthreads();
            mm64<false, true>(Tacc, SL(2), SL(5), mt, nt0, lane);
            st_tile(SL(10), Tacc[0], mt, nt0, lane); st_tile(SL(10), Tacc[1], mt, nt0 + 1, lane);
            __syncthreads();
            ZERO2(acc); mm64<false, true>(acc, SL(12), SL(10), mt, nt0, lane);
            st_tile(SL(5), acc[0], mt, nt0, lane); st_tile(SL(5), acc[1], mt, nt0 + 1, lane);
            __syncthreads();
            mm64<false, true>(Tacc, SL(10), SL(5), mt, nt0, lane);
            st_tile(SL(2), Tacc[0], mt, nt0, lane); st_tile(SL(2), Tacc[1], mt, nt0 + 1, lane);
            __syncthreads();
            ZERO2(acc); mm64<false, true>(acc, SL(13), SL(2), mt, nt0, lane);
            st_tile(SL(6), acc[0], mt, nt0, lane); st_tile(SL(6), acc[1], mt, nt0 + 1, lane);
            __syncthreads();
            mm64<false, true>(Tacc, SL(2), SL(6), mt, nt0, lane);
            st_tile(SL(10), Tacc[0], mt, nt0, lane); st_tile(SL(10), Tacc[1], mt, nt0 + 1, lane);
            __syncthreads();
            ZERO2(acc); mm64<false, true>(acc, SL(10), SL(0), mt, nt0, lane);
            st_tile(SL(7), acc[0], mt, nt0, lane); st_tile(SL(7), acc[1], mt, nt0 + 1, lane);
            ZERO2(acc); mm64<false, true>(acc, SL(10), SL(11), mt, nt0, lane);
            st_tile(SL(9), acc[0], mt, nt0, lane); st_tile(SL(9), acc[1], mt, nt0 + 1, lane);
            __syncthreads();
            ZERO2(acc); mm64<true, true>(acc, SL(1), SL(7), mt, nt0, lane);
#pragma unroll
            for (int n = 0; n < 2; ++n)
#pragma unroll
                for (int i = 0; i < 4; ++i) { const int row = mt * 16 + 4 * g + i, col = (nt0 + n) * 16 + (lane & 15); acc[n][i] = gc[row] * (acc[n][i] + (row == col ? 1.f : 0.f)); }
            st_tile(SL(12), acc[0], mt, nt0, lane); st_tile(SL(12), acc[1], mt, nt0 + 1, lane);
            mm64<true, true>(P2acc, SL(1), SL(9), mt, nt0, lane);
#pragma unroll
            for (int n = 0; n < 2; ++n)
#pragma unroll
                for (int i = 0; i < 4; ++i) P2acc[n][i] *= gc[mt * 16 + 4 * g + i];
#pragma unroll
            for (int n = 0; n < 2; ++n)
#pragma unroll
                for (int i = 0; i < 4; ++i) acc[n][i] = bf2f(*(const LAS u16*)(SL(3) + (mt * 16 + 4 * g + i) * SM_STR + ((nt0 + n) * 16 + (lane & 15)) * 2));
            mm64<false, true>(acc, SL(8), SL(7), mt, nt0, lane);
            st_tile(SL(13), acc[0], mt, nt0, lane); st_tile(SL(13), acc[1], mt, nt0 + 1, lane);
            mm64<false, true>(AVacc, SL(8), SL(9), mt, nt0, lane);
            __syncthreads();
            mm64<false, true>(AVacc, SL(13), SL(14), mt, nt0, lane); mm64<false, true>(AVacc, SL(13), SL(15), mt, nt0, lane);
            mm64<false, true>(P2acc, SL(12), SL(14), mt, nt0, lane); mm64<false, true>(P2acc, SL(12), SL(15), mt, nt0, lane);
            if (c >= CTXL / 64) {
#pragma unroll
                for (int n = 0; n < 2; ++n)
#pragma unroll
                    for (int i = 0; i < 4; ++i) {
                        const int tq = mt * 16 + 4 * g + i;
                        const int nn = SCAN_N(c * 64 + tq);
                        yb[(size_t)(b * SEQ + nn - CTXL) * D + h * 64 + (nt0 + n) * 16 + (lane & 15)] = AVacc[n][i];
                    }
            }
            __syncthreads();
#pragma unroll
            for (int n = 0; n < 2; ++n)
#pragma unroll
                for (int i = 0; i < 4; ++i) {
                    const float hv = P2acc[n][i];
                    const u16 hi = f2bf(hv); const u16 lo = f2bf(hv - bf2f(hi));
                    const int off = (mt * 16 + 4 * g + i) * SM_STR + ((nt0 + n) * 16 + (lane & 15)) * 2;
                    *(LAS u16*)(SL(14) + off) = hi; *(LAS u16*)(SL(15) + off) = lo;
                }
        }
#undef LOADC
#undef SCAN_N
    }
#undef SL
}

DI void phase_post(const Params& p) {
    const int lane = threadIdx.x & 63, wave = threadIdx.x >> 6;
    const float* y0b = (const float*)(p.ws + WS_Y); const float* y1b = y0b + (size_t)TL * D;
    const u16* rb = (const u16*)(p.ws + WS_R); const u16* kb = (const u16*)(p.ws + WS_K); const u16* vb = (const u16*)(p.ws + WS_V);
    const u16* a0b = (const u16*)(p.ws + WS_A0); const u16* a1b = a0b + (size_t)T * D;
    const u16* gb = (const u16*)(p.ws + WS_G); u16* ao = (u16*)(p.ws + WS_AO);
    const float* lnx0 = p.in[27]; const float* lnx1 = p.in[27] + D; const float* kaw = p.in[25]; const float* rkw = p.in[26];
    for (int m = blockIdx.x * 8 + wave; m < TL; m += gridDim.x * 8) {
        const int row = (m >> 11) * NTOK + CTXL + (m & 2047);
#pragma unroll
        for (int j = 0; j < 4; ++j) {
            const int col = lane * 4 + 256 * j;
            const f32x4 y = *(const f32x4*)(y0b + (size_t)m * D + col) + *(const f32x4*)(y1b + (size_t)m * D + col);
            const float ym = wsum16(y[0] + y[1] + y[2] + y[3]) * (1.f / 64.f);
            const f32x4 d = y - ym;
            const float yv = wsum16(d[0] * d[0] + d[1] * d[1] + d[2] * d[2] + d[3] * d[3]) * (1.f / 64.f);
            const f32x4 yn = d * rsqrtf(yv + 64e-5f) * *(const f32x4*)(lnx0 + col) + *(const f32x4*)(lnx1 + col);
            const size_t o = (size_t)row * D + col;
            const f32x4 r = ld_bf4(rb + o), k = ld_bf4(kb + o), vv = ld_bf4(vb + o);
            const f32x4 a0 = ld_bf4(a0b + o), a1 = ld_bf4(a1b + o);
            const f32x4 ks = k * (2.f + (a0 + a1 - 2.f) * *(const f32x4*)(kaw + col));
            const f32x4 t = r * ks * *(const f32x4*)(rkw + col);
            const float bs = wsum16(t[0] + t[1] + t[2] + t[3]);
            const f32x4 outv = (yn + bs * vv) * ld_bf4(gb + o);
            u32x2 ov; ov[0] = pack2(outv[0], outv[1]); ov[1] = pack2(outv[2], outv[3]);
            *(u32x2*)(ao + o) = ov;
        }
    }
}

constexpr int NPH = 25;
__global__ void __launch_bounds__(NTHR, 2) mk_fwd(Params p) {
    extern __shared__ __attribute__((aligned(16))) unsigned char lds_raw[];
    ldsp lds = (ldsp)lds_raw;
    if (threadIdx.x < 4) ((LAS unsigned*)lds)[threadIdx.x] = 0u;
    __syncthreads();
    const bool multi = (p.ph_hi - p.ph_lo) > 1;
    XcdBarrier bar; bar.bar = (unsigned*)(p.ws + WS_CTL); bar.x = 0; bar.st = (volatile LAS unsigned*)lds;
    if (multi) bar = xcd_barrier_post((unsigned*)(p.ws + WS_CTL), (volatile LAS unsigned*)lds);
    const int lo = p.ph_lo, hi = p.ph_hi;
#define IN(k) (lo <= (k) && (k) < hi)
#define SEAM(k) do { if (IN(k) && IN((k) + 1)) xcd_barrier(bar); } while (0)
    u16* ubuf = (u16*)(p.ws + WS_U); u16* hp = (u16*)(p.ws + WS_HP); u16* ao = (u16*)(p.ws + WS_AO);
    float* zbuf = (float*)(p.ws + WS_Z); float* hbuf = (float*)(p.ws + WS_H);
    const float* modbase = (const float*)(p.ws + WS_MODS);

    if (IN(0)) { phase_ada(p, lds); phase_cvt(p, lds); } SEAM(0);
    if (IN(1)) { phase_mod0(p); } SEAM(1);
#ifdef PROBE_INPROJ2
    if (IN(2)) {
        LAS f32x2* tab = (LAS f32x2*)(lds + LDS_MISC);
        gemm_phase(lds, ubuf, D, T, BtDesc{(const u16*)(p.ws + WB_WIN), D, D, HPW}, RowAll{}, EpiInProj{hp, tab});
        xcd_barrier(bar);
    }
#endif
    if (IN(2)) {
        LAS f32x2* tab = (LAS f32x2*)(lds + LDS_PG8_TAB);
        __syncthreads();
        for (int i = threadIdx.x; i < 1024; i += NTHR) {
            const int pos = i >> 4, f = i & 15;
            const float inv = exp2f(-(float)f * (13.287712379549449f / 16.f));
            const float ang = (float)pos * inv;
            tab[i] = (f32x2){cosf(ang), sinf(ang)};
        }
        __syncthreads();
        pg8::Order S; S.init(T, HPW, 1, gridDim.x, blockIdx.x);
        pg8::gemm_phase(lds + LDS_BASE, D, S, pg8::AddrOne{ubuf, (const u16*)(p.ws + WB_WIN), D, false}, pg8::EpiInProjP{hp, tab});
    } SEAM(2);
#ifdef PROBE_ATTN2
    if (IN(3)) { phase_attn(p, lds); xcd_barrier(bar); }
#endif
    if (IN(3)) { phase_attn(p, lds); } SEAM(3);
    if (IN(4)) { pg8::Order S; S.init(T, D, 1, gridDim.x, blockIdx.x); __syncthreads();
        pg8::gemm_phase(lds + LDS_BASE, D, S, pg8::AddrOne{ao, (const u16*)(p.ws + WB_WOUT), D, false}, pg8::EpiResidP{zbuf, hbuf, modbase, 0, false}); } SEAM(4);
    if (IN(5)) { phase_ln<0>(p, 0, false); } SEAM(5);
    if (IN(6)) { gemm_phase_f32(lds, ubuf, D, T, 256, D, RowAll{}, MakeBDenseF{p.in[28], 256, D, 256}, EpiSigScore{(float*)(p.ws + WS_SC)});
                 bg_idle_run(p, T / 128, bg_s1(), bg_s2()); } SEAM(6);
    if (IN(7)) { phase_topk(p, 0, T, lds); } SEAM(7);
    if (IN(8)) { phase_fill4(p, 0, T, false, lds); } SEAM(8);
    if (IN(9)) { phase_experts4_g1(p, 0, T, false, lds); } SEAM(9);
    if (IN(10)) { phase_experts4_g2(p, 0, T, lds, (u16*)(p.ws + WS_SLOT), (u16*)(p.ws + WS_SH)); } SEAM(10);
    if (IN(11)) { phase_ln<1>(p, 0, false); } SEAM(11);
    if (IN(12)) { phase_mix(p); } SEAM(12);
#ifdef PROBE_R2
    for (int rep = 0; rep < 2; ++rep)
#endif
    if (IN(13)) {
        pg8::OrderRkvLora S; S.init(gridDim.x, blockIdx.x); __syncthreads();
        pg8::gemm_phase_s(lds + LDS_BASE, D, S, pg8::AddrRkvLora{p.ws}, pg8::EpiRkvLora{p.ws});
    } SEAM(13);
#ifdef PROBE_R3
    for (int rep = 0; rep < 2; ++rep)
#endif
    if (IN(14)) {
        const int G_ = (int)gridDim.x, q_ = (int)blockIdx.x % 5, mem_ = (int)blockIdx.x / 5, str_ = (G_ - q_ + 4) / 5;
        if (G_ >= 5) {
            if (q_ < 4) {
                const int d = q_ & 1;
                if (q_ < 2) gemm_phase(lds, (const u16*)(p.ws + WS_LW) + 64 * d, 128, T, BtDesc{(const u16*)(p.ws + WB_DEC2) + (size_t)d * 64 * D, 64, 64, D}, RowAll{},
                                       EpiDecay{(float*)(p.ws + WS_W0) + (size_t)d * T * D, p.in[16] + d * D}, mem_, str_);
                else        gemm_phase(lds, (const u16*)(p.ws + WS_LA) + 64 * d, 128, T, BtDesc{(const u16*)(p.ws + WB_ICL2) + (size_t)d * 64 * D, 64, 64, D}, RowAll{},
                                       EpiSigBias{(u16*)(p.ws + WS_A0) + (size_t)d * T * D, p.in[19] + d * D}, mem_, str_);
            } else {
                gemm_phase(lds, (const u16*)(p.ws + WS_SG), 192, T, BtDesc{(const u16*)(p.ws + WB_G2), 192, 160, D}, RowAll{}, EpiBf16<0>{(u16*)(p.ws + WS_G), D, D}, mem_, str_);
            }
        } else {
            for (int d = 0; d < 2; ++d) {
                gemm_phase(lds, (const u16*)(p.ws + WS_LW) + 64 * d, 128, T, BtDesc{(const u16*)(p.ws + WB_DEC2) + (size_t)d * 64 * D, 64, 64, D}, RowAll{},
                           EpiDecay{(float*)(p.ws + WS_W0) + (size_t)d * T * D, p.in[16] + d * D});
                gemm_phase(lds, (const u16*)(p.ws + WS_LA) + 64 * d, 128, T, BtDesc{(const u16*)(p.ws + WB_ICL2) + (size_t)d * 64 * D, 64, 64, D}, RowAll{},
                           EpiSigBias{(u16*)(p.ws + WS_A0) + (size_t)d * T * D, p.in[19] + d * D});
            }
            gemm_phase(lds, (const u16*)(p.ws + WS_SG), 192, T, BtDesc{(const u16*)(p.ws + WB_G2), 192, 160, D}, RowAll{}, EpiBf16<0>{(u16*)(p.ws + WS_G), D, D});
        }
    } SEAM(14);
    if (IN(15)) { phase_scan(p, lds); } SEAM(15);
    if (IN(16)) { phase_post(p); } SEAM(16);
    if (IN(17)) { pg8::Order S; S.init(TL, D, 1, gridDim.x, blockIdx.x); __syncthreads();
        pg8::gemm_phase(lds + LDS_BASE, D, S, pg8::AddrOne{ao, (const u16*)(p.ws + WB_RKO), D, true}, pg8::EpiResidP{zbuf, hbuf, modbase, 1, true}); } SEAM(17);
    if (IN(18)) { phase_ln<0>(p, 1, true); } SEAM(18);
    if (IN(19)) { gemm_phase_f32(lds, ubuf, D, TL, 256, D, RowLat{}, MakeBDenseF{p.in[28] + (size_t)D * 256, 256, D, 256}, EpiSigScore{(float*)(p.ws + WS_SC)});
                  bg_idle_run(p, TL / 128, bg_s2(), BG_NSTRIP); } SEAM(19);
    if (IN(20)) { phase_topk(p, 1, TL, lds); } SEAM(20);
    if (IN(21)) { phase_fill4(p, 1, TL, true, lds); } SEAM(21);
    if (IN(22)) { phase_experts4_g1(p, 1, TL, true, lds); } SEAM(22);
    if (IN(23)) { phase_experts4_g2(p, 1, TL, lds, (u16*)(p.ws + WS_SLOT), (u16*)(p.ws + WS_SH)); } SEAM(23);
    if (IN(24)) { phase_ln<2>(p, 1, true); }
#undef IN
#undef SEAM
}

extern "C" void kernel_launch(void* const* d_in, const int* in_sizes, int n_in, void* d_out, int out_size, void* d_ws, size_t ws_size, hipStream_t stream) {
    static int grid = 0;
    if (grid == 0) {
        if (n_in != 34 || ws_size < WS_END) { fprintf(stderr, "kernel_launch: unexpected n_in %d / ws %zu (need %zu)\n", n_in, ws_size, (size_t)WS_END); grid = -1; return; }
        int dev = 0, cus = 0;
        if (hipGetDevice(&dev) != hipSuccess || hipDeviceGetAttribute(&cus, hipDeviceAttributeMultiprocessorCount, dev) != hipSuccess) { grid = -1; return; }
        if (hipFuncSetAttribute((const void*)mk_fwd, hipFuncAttributeMaxDynamicSharedMemorySize, LDS_BYTES) != hipSuccess) { fprintf(stderr, "kernel_launch: hipFuncSetAttribute failed\n"); grid = -1; return; }
        int per_cu = 0;
        if (hipOccupancyMaxActiveBlocksPerMultiprocessor(&per_cu, (const void*)mk_fwd, NTHR, LDS_BYTES) != hipSuccess || per_cu < 1) fprintf(stderr, "kernel_launch: occupancy query says %d\n", per_cu);
        (void)hipGetLastError();
        grid = cus;
    }
    if (grid < 0) return;
    (void)hipMemsetAsync((char*)d_ws + WS_CTL, 0, CTL_BYTES, stream);
    Params p{};
    for (int i = 0; i < 34; ++i) p.in[i] = (const float*)d_in[i];
    p.out = (float*)d_out; p.ws = (unsigned char*)d_ws;
#if MK_ONE_LAUNCH
    p.ph_lo = 0; p.ph_hi = NPH;
    hipLaunchKernelGGL(mk_fwd, dim3(grid), dim3(NTHR), LDS_BYTES, stream, p);
#else
    for (int ph = 0; ph < NPH; ++ph) { p.ph_lo = ph; p.ph_hi = ph + 1; hipLaunchKernelGGL(mk_fwd, dim3(grid), dim3(NTHR), LDS_BYTES, stream, p); }
#endif
}
```

```cpp
#include <hip/hip_runtime.h>
#include <cstdio>
#include <cstdint>

#ifndef MK_ONE_LAUNCH
#define MK_ONE_LAUNCH 1
#endif

typedef unsigned short u16;
typedef short s16x8 __attribute__((ext_vector_type(8)));
typedef short s16x4 __attribute__((ext_vector_type(4)));
typedef short v4i16_t __attribute__((ext_vector_type(4)));
typedef float f32x4 __attribute__((ext_vector_type(4)));
typedef float f32x2 __attribute__((ext_vector_type(2)));
typedef unsigned u32x4 __attribute__((ext_vector_type(4)));
typedef unsigned u32x2 __attribute__((ext_vector_type(2)));
typedef int i32x4 __attribute__((ext_vector_type(4)));
typedef __bf16 bf16x2_t __attribute__((ext_vector_type(2)));
#define LAS __attribute__((address_space(3)))
#define DI __device__ __forceinline__
typedef LAS unsigned char* ldsp;

#define XB_TMO      128
#define XB_XCNT(j)  (256  + 64 * (j))
#define XB_XSUB(j)  (1280 + 64 * (j))
#define XB_XGEN(j)  (2304 + 64 * (j))
#define XB_TOP      3328
#define XB_TOPGEN   3392
#define XCD_BAR_WORDS 3456
#define XB_SPIN_CAP (1u << 18)

__device__ __forceinline__ unsigned xb_ld(unsigned* p)              { return __hip_atomic_load(p, __ATOMIC_RELAXED, __HIP_MEMORY_SCOPE_AGENT); }
__device__ __forceinline__ unsigned xb_add(unsigned* p, unsigned v) { return __hip_atomic_fetch_add(p, v, __ATOMIC_RELAXED, __HIP_MEMORY_SCOPE_AGENT); }
__device__ __forceinline__ unsigned xb_xcc_id() { return (unsigned)__builtin_amdgcn_s_getreg((3 << 11) | 20) & 0xFu; }
#define XB_SPIN(cond, bar) do { unsigned _sp = 0; while (cond) { __builtin_amdgcn_s_sleep(1); \
    if ((++_sp & 255u) == 0u) { if (xb_ld(&(bar)[XB_TMO])) break; if (_sp > XB_SPIN_CAP) { atomicAdd(&(bar)[XB_TMO], 1u); break; } } } } while (0)

struct XcdBarrier {
    unsigned* bar; unsigned x;
    volatile LAS unsigned* st;
};

__device__ __forceinline__ XcdBarrier xcd_barrier_post(unsigned* bar, volatile LAS unsigned* st) {
    XcdBarrier b; b.bar = bar; b.x = xb_xcc_id(); b.st = st;
    if (threadIdx.x == 0) (void)xb_add(&bar[XB_XCNT(b.x)], 1u);
    return b;
}
__device__ __forceinline__ void xcd_barrier_complete(unsigned* bar, unsigned x, unsigned& nloc, unsigned& nx) {
    const unsigned G = gridDim.x * gridDim.y * gridDim.z;
    unsigned sum, cnt, mine, sp = 0u;
    for (;;) {
        sum = 0u; cnt = 0u; mine = 0u;
#pragma unroll
        for (unsigned j = 0; j < 16; ++j) { const unsigned c = xb_ld(&bar[XB_XCNT(j)]); sum += c; cnt += (c > 0u) ? 1u : 0u; mine = (j == x) ? c : mine; }
        if (sum == G) break;
        __builtin_amdgcn_s_sleep(1);
        if ((++sp & 255u) == 0u) { if (xb_ld(&bar[XB_TMO])) break; if (sp > XB_SPIN_CAP) { atomicAdd(&bar[XB_TMO], 1u); break; } }
    }
    nloc = mine > 0u ? mine : 1u; nx = cnt > 0u ? cnt : 1u;
}

__device__ __forceinline__ void xcd_barrier(const XcdBarrier& b) {
    asm volatile("s_waitcnt vmcnt(0)" ::: "memory");
    __syncthreads();
    if (threadIdx.x == 0) {
        unsigned* bar = b.bar;
        __builtin_amdgcn_s_waitcnt(0);
        unsigned nloc = b.st[0], nx = b.st[1];
        if (nloc == 0u) { xcd_barrier_complete(bar, b.x, nloc, nx); b.st[0] = nloc; b.st[1] = nx; }
        const unsigned old = xb_add(&bar[XB_XSUB(b.x)], 1u);
        const unsigned gen = old / nloc;
        if (old + 1u == (gen + 1u) * nloc) {
            __builtin_amdgcn_fence(__ATOMIC_RELEASE, "agent");
            asm volatile("s_waitcnt vmcnt(0)" ::: "memory");
            const unsigned og = xb_add(&bar[XB_TOP], 1u);
            const unsigned tg = og / nx;
            if (og + 1u == (tg + 1u) * nx) xb_add(&bar[XB_TOPGEN], 1u);
            else XB_SPIN(xb_ld(&bar[XB_TOPGEN]) == tg, bar);
            __builtin_amdgcn_fence(__ATOMIC_ACQUIRE, "agent");
            xb_add(&bar[XB_XGEN(b.x)], 1u);
            asm volatile("s_waitcnt vmcnt(0)" ::: "memory");
        } else {
            XB_SPIN(xb_ld(&bar[XB_XGEN(b.x)]) == gen, bar);
            __builtin_amdgcn_fence(__ATOMIC_ACQUIRE, "agent");
            asm volatile("s_waitcnt vmcnt(0)" ::: "memory");
        }
    }
    __syncthreads();
}

constexpr int D = 1024, NBATCH = 8, SEQ = 2048, CTXL = 256, NTOK = 2304;
constexpr int T = NBATCH * NTOK;
constexpr int TL = NBATCH * SEQ;
constexpr int HPW = 2304;
constexpr float ALPHA = 1.41421356237309515f;
constexpr float LN_EPS = 1e-5f;
constexpr float L2E = 1.4426950408889634f;
constexpr int NTHR = 512;

constexpr size_t al256(size_t x) { return (x + 255) & ~(size_t)255; }
constexpr size_t WS_CTL  = 0;
constexpr int CNT_STR = 64;
constexpr size_t CTL_CNT = 16384;
constexpr size_t CTL_BYTES = CTL_CNT + (size_t)2 * 256 * CNT_STR * 4;
constexpr size_t WS_MODS = WS_CTL + CTL_BYTES;
constexpr size_t WS_H    = al256(WS_MODS + 2 * 9 * 6144 * 4);
constexpr size_t WS_U    = al256(WS_H + (size_t)T * D * 4);
constexpr size_t WS_HP   = al256(WS_U + (size_t)T * D * 2);
constexpr size_t WS_AO   = al256(WS_HP + (size_t)T * HPW * 2);
constexpr size_t WS_Z    = al256(WS_AO + (size_t)T * D * 2);
constexpr size_t WS_ACC  = al256(WS_Z + (size_t)T * D * 4);
constexpr size_t WS_SC   = al256(WS_ACC + (size_t)T * D * 4);
constexpr size_t WS_EIDX = al256(WS_SC + (size_t)T * 256 * 4);
constexpr size_t WS_GW   = al256(WS_EIDX + (size_t)T * 8 * 4);
constexpr size_t WS_EPOS = al256(WS_GW + (size_t)T * 8 * 4);
constexpr size_t WS_RTOK = al256(WS_EPOS + (size_t)T * 8 * 4);
constexpr size_t WS_RW   = al256(WS_RTOK + (size_t)T * 8 * 4);
constexpr size_t WS_XMIX = al256(WS_RW + (size_t)T * 8 * 4);
constexpr size_t WS_R    = al256(WS_XMIX + (size_t)6 * T * D * 2);
constexpr size_t WS_K    = al256(WS_R + (size_t)T * D * 4);
constexpr size_t WS_V    = al256(WS_K + (size_t)T * D * 4);
constexpr size_t WS_KK   = al256(WS_V + (size_t)T * D * 4);
constexpr size_t WS_W0   = al256(WS_KK + (size_t)T * D * 4);
constexpr size_t WS_A0   = al256(WS_W0 + (size_t)2 * T * D * 4);
constexpr size_t WS_G    = al256(WS_A0 + (size_t)2 * T * D * 4);
constexpr size_t WS_LW   = al256(WS_G + (size_t)T * D * 4);
constexpr size_t WS_LA   = al256(WS_LW + (size_t)T * 128 * 2);
constexpr size_t WS_SG   = al256(WS_LA + (size_t)T * 128 * 2);
constexpr size_t WS_Y    = al256(WS_SG + (size_t)T * 192 * 2);
constexpr size_t WS_SLOT = al256(WS_Y + (size_t)2 * TL * D * 4);
constexpr size_t WS_SH   = al256(WS_SLOT + (size_t)T * 8 * D * 2);
constexpr size_t WB_WIN  = al256(WS_SH + (size_t)T * D * 2);
constexpr size_t WB_WOUT = al256(WB_WIN + (size_t)1024 * 2304 * 2);
constexpr size_t WB_RKV  = al256(WB_WOUT + (size_t)1024 * 1024 * 2);
constexpr size_t WB_RKO  = al256(WB_RKV + (size_t)3 * 1024 * 1024 * 2);
constexpr size_t WB_RT   = al256(WB_RKO + (size_t)1024 * 1024 * 2);
constexpr size_t WB_DEC1 = al256(WB_RT + (size_t)2 * 1024 * 256 * 2);
constexpr size_t WB_ICL1 = al256(WB_DEC1 + (size_t)1024 * 256 * 2);
constexpr size_t WB_G1   = al256(WB_ICL1 + (size_t)1024 * 256 * 2);
constexpr size_t WB_DEC2 = al256(WB_G1 + (size_t)1024 * 256 * 2);
constexpr size_t WB_ICL2 = al256(WB_DEC2 + (size_t)2 * 64 * 1024 * 2);
constexpr size_t WB_G2   = al256(WB_ICL2 + (size_t)2 * 64 * 1024 * 2);
constexpr size_t WB_EIN  = al256(WB_G2 + (size_t)192 * 1024 * 2);
constexpr size_t WB_EOUT = al256(WB_EIN + (size_t)2 * 256 * 1024 * 512 * 2);
constexpr size_t WB_SIN  = al256(WB_EOUT + (size_t)2 * 256 * 256 * 1024 * 2);
constexpr size_t WB_SOUT = al256(WB_SIN + (size_t)2 * 1024 * 512 * 2);
constexpr int NPMAX = T * 8 + 256 * 256;
constexpr size_t WT_IN   = al256(WB_SOUT + (size_t)2 * 256 * 1024 * 2);
constexpr size_t WT_OUT  = al256(WT_IN + (size_t)2 * 257 * 512 * 1024 * 2);
constexpr size_t WS_HG   = al256(WT_OUT + (size_t)2 * 257 * 1024 * 256 * 2);
constexpr size_t WS_AROW = al256(WS_HG + (size_t)(NPMAX + T) * 256 * 2);
constexpr size_t WS_RTK2 = al256(WS_AROW + (size_t)NPMAX * 4);
constexpr size_t WS_RW2  = al256(WS_RTK2 + (size_t)NPMAX * 4);
constexpr size_t WS_END  = al256(WS_RW2 + (size_t)NPMAX * 4);

constexpr int LDS_BASE = 256;
constexpr int A_STR = 144;
constexpr int B_STR = 528;
constexpr int LDS_AS = LDS_BASE;
constexpr int LDS_BS = LDS_AS + 128 * A_STR;
constexpr int LDS_HS = LDS_BS + 64 * B_STR;
constexpr int LDS_MISC = LDS_HS + 128 * B_STR;
constexpr int LDS_BYTES = 152 * 1024;

struct Params {
    const float* in[34];
    float* out;
    unsigned char* ws;
    int ph_lo, ph_hi;
};

DI float bf2f(u16 x) { return __uint_as_float(((unsigned)x) << 16); }
DI unsigned pack2(float a, float b) { f32x2 v = {a, b}; bf16x2_t r = __builtin_convertvector(v, bf16x2_t); return __builtin_bit_cast(unsigned, r); }
DI u16 f2bf(float a) { return (u16)(pack2(a, 0.f) & 0xffffu); }
DI s16x4 vtr(const LAS unsigned char* p) { return __builtin_bit_cast(s16x4, __builtin_amdgcn_ds_read_tr16_b64_v4i16((LAS v4i16_t*)p)); }
DI float sigmoidf_(float x) { return __builtin_amdgcn_rcpf(1.f + __expf(-x)); }
DI float siluf_(float x) { return x * __builtin_amdgcn_rcpf(1.f + __expf(-x)); }
DI float wsum64(float v) { v += __shfl_xor(v, 32); v += __shfl_xor(v, 16); v += __shfl_xor(v, 8); v += __shfl_xor(v, 4); v += __shfl_xor(v, 2); v += __shfl_xor(v, 1); return v; }
DI float wsum16(float v) { v += __shfl_xor(v, 8); v += __shfl_xor(v, 4); v += __shfl_xor(v, 2); v += __shfl_xor(v, 1); return v; }
DI const float* mods_ptr(const Params& p, int layer, int mrow, int j) { return (const float*)(p.ws + WS_MODS) + ((size_t)(layer * 9 + mrow) * 6 + j) * 1024; }
DI f32x4 ld_bf4(const u16* p) { const u32x2 v = *(const u32x2*)p; return (f32x4){bf2f((u16)(v[0] & 0xffffu)), bf2f((u16)(v[0] >> 16)), bf2f((u16)(v[1] & 0xffffu)), bf2f((u16)(v[1] >> 16))}; }
DI int modrow_of(int row) { int b = row / NTOK; int n = row - b * NTOK; return n < CTXL ? 8 : b; }

template <int ASTR>
DI void mma_ktile(f32x4 (&acc)[4][4], const LAS unsigned char* a_ptr, const LAS unsigned char* b_ptr) {
#pragma unroll
    for (int ks = 0; ks < 2; ++ks) {
        s16x8 a[4], b[4];
#pragma unroll
        for (int mt = 0; mt < 4; ++mt) a[mt] = *(const LAS s16x8*)(a_ptr + mt * 16 * ASTR + ks * 64);
#pragma unroll
        for (int nt = 0; nt < 4; ++nt) {
            s16x4 lo = vtr(b_ptr + ks * 32 * B_STR + nt * 32);
            s16x4 hi = vtr(b_ptr + ks * 32 * B_STR + 4 * B_STR + nt * 32);
            b[nt] = (s16x8){lo[0], lo[1], lo[2], lo[3], hi[0], hi[1], hi[2], hi[3]};
        }
#pragma unroll
        for (int mt = 0; mt < 4; ++mt)
#pragma unroll
            for (int nt = 0; nt < 4; ++nt)
                acc[mt][nt] = __builtin_amdgcn_mfma_f32_16x16x32_bf16(a[mt], b[nt], acc[mt][nt], 0, 0, 0);
    }
}

template <bool HAS_A, int ASTR, class ALoad, class BLoad>
DI void gemm_kloop(ldsp lds, int nkt, const ALoad& aload, const BLoad& bload, f32x4 (&acc)[4][4], const LAS unsigned char* a_res) {
    const int tid = threadIdx.x, lane = tid & 63, wave = tid >> 6, wr = wave >> 2, wc = wave & 3;
    ldsp As = lds + LDS_AS; ldsp Bs = lds + LDS_BS;
    const LAS unsigned char* a_ptr = HAS_A ? (As + (wr * 64 + (lane & 15)) * ASTR + (lane >> 4) * 16)
                                           : (a_res + (wr * 64 + (lane & 15)) * ASTR + (lane >> 4) * 16);
    const LAS unsigned char* b_ptr = Bs + (8 * (lane >> 4) + ((lane >> 2) & 3)) * B_STR + (wc * 64 + 4 * (lane & 3)) * 2;
    u32x4 ra[2]; f32x4 rb[8];
    if (HAS_A) {
#pragma unroll
        for (int s = 0; s < 2; ++s) { int c = tid + 512 * s; ra[s] = aload(c >> 3, (c & 7) * 8); }
    }
#pragma unroll
    for (int s = 0; s < 8; ++s) rb[s] = bload(wave + 8 * s, lane * 4);
    for (int kt = 0; kt < nkt; ++kt) {
        __syncthreads();
        if (HAS_A) {
#pragma unroll
            for (int s = 0; s < 2; ++s) { int c = tid + 512 * s; *(LAS u32x4*)(As + (c >> 3) * ASTR + (c & 7) * 16) = ra[s]; }
        }
#pragma unroll
        for (int s = 0; s < 8; ++s) {
            u32x2 v; v[0] = pack2(rb[s][0], rb[s][1]); v[1] = pack2(rb[s][2], rb[s][3]);
            *(LAS u32x2*)(Bs + (wave + 8 * s) * B_STR + lane * 8) = v;
        }
        __syncthreads();
        {
            const int k0 = ((kt + 1 < nkt) ? kt + 1 : kt) * 64;
            if (HAS_A) {
#pragma unroll
                for (int s = 0; s < 2; ++s) { int c = tid + 512 * s; ra[s] = aload(c >> 3, k0 + (c & 7) * 8); }
            }
#pragma unroll
            for (int s = 0; s < 8; ++s) rb[s] = bload(k0 + wave + 8 * s, lane * 4);
        }
        mma_ktile<ASTR>(acc, a_ptr + (HAS_A ? 0 : kt * 128), b_ptr);
    }
}

template <class ALoad, class BLoad16>
DI void gemm_kloop16(ldsp lds, int nkt, const ALoad& aload, const BLoad16& bload, f32x4 (&acc)[4][4]) {
    const int tid = threadIdx.x, lane = tid & 63, wave = tid >> 6, wr = wave >> 2, wc = wave & 3;
    ldsp As = lds + LDS_AS; ldsp Bs = lds + LDS_BS;
    const LAS unsigned char* a_ptr = As + (wr * 64 + (lane & 15)) * A_STR + (lane >> 4) * 16;
    const LAS unsigned char* b_ptr = Bs + (8 * (lane >> 4) + ((lane >> 2) & 3)) * B_STR + (wc * 64 + 4 * (lane & 3)) * 2;
    const int bk = tid >> 5, bc = (tid & 31) * 8;
    u32x4 ra0[2], ra1[2], rb0[4], rb1[4];
#define GK_LOAD(RA, RB, KT) do { const int k0_ = (KT) * 64; \
        _Pragma("unroll") for (int s_ = 0; s_ < 2; ++s_) { const int c_ = tid + 512 * s_; RA[s_] = aload(c_ >> 3, k0_ + (c_ & 7) * 8); } \
        _Pragma("unroll") for (int s_ = 0; s_ < 4; ++s_) RB[s_] = bload(k0_ + bk + 16 * s_, bc); } while (0)
#define GK_STEP(RA, RB, KT) do { \
        __syncthreads(); \
        _Pragma("unroll") for (int s_ = 0; s_ < 2; ++s_) { const int c_ = tid + 512 * s_; *(LAS u32x4*)(As + (c_ >> 3) * A_STR + (c_ & 7) * 16) = RA[s_]; } \
        _Pragma("unroll") for (int s_ = 0; s_ < 4; ++s_) *(LAS u32x4*)(Bs + (bk + 16 * s_) * B_STR + bc * 2) = RB[s_]; \
        __syncthreads(); \
        if ((KT) + 2 < nkt) GK_LOAD(RA, RB, (KT) + 2); \
        mma_ktile<A_STR>(acc, a_ptr, b_ptr); } while (0)
    GK_LOAD(ra0, rb0, 0);
    if (nkt > 1) GK_LOAD(ra1, rb1, 1);
    for (int kt = 0; kt < nkt; kt += 2) {
        GK_STEP(ra0, rb0, kt);
        if (kt + 1 < nkt) GK_STEP(ra1, rb1, kt + 1);
    }
#undef GK_LOAD
#undef GK_STEP
}

template <bool HAS_A, int ASTR, class ALoad, class BLoad16>
DI void gemm_kloop16(ldsp lds, int nkt, const ALoad& aload, const BLoad16& bload, f32x4 (&acc)[4][4], const LAS unsigned char* a_res) {
    const int tid = threadIdx.x, lane = tid & 63, wave = tid >> 6, wr = wave >> 2, wc = wave & 3;
    ldsp As = lds + LDS_AS; ldsp Bs = lds + LDS_BS;
    const LAS unsigned char* a_ptr = HAS_A ? (As + (wr * 64 + (lane & 15)) * ASTR + (lane >> 4) * 16)
                                           : (a_res + (wr * 64 + (lane & 15)) * ASTR + (lane >> 4) * 16);
    const LAS unsigned char* b_ptr = Bs + (8 * (lane >> 4) + ((lane >> 2) & 3)) * B_STR + (wc * 64 + 4 * (lane & 3)) * 2;
    const int bk = tid >> 5, bc = (tid & 31) * 8;
    u32x4 ra0[2], ra1[2], rb0[4], rb1[4];
#define GK_LOAD(RA, RB, KT) do { const int k0_ = (KT) * 64; \
        if (HAS_A) { _Pragma("unroll") for (int s_ = 0; s_ < 2; ++s_) { const int c_ = tid + 512 * s_; RA[s_] = aload(c_ >> 3, k0_ + (c_ & 7) * 8); } } \
        _Pragma("unroll") for (int s_ = 0; s_ < 4; ++s_) RB[s_] = bload(k0_ + bk + 16 * s_, bc); } while (0)
#define GK_STEP(RA, RB, KT) do { \
        __syncthreads(); \
        if (HAS_A) { _Pragma("unroll") for (int s_ = 0; s_ < 2; ++s_) { const int c_ = tid + 512 * s_; *(LAS u32x4*)(As + (c_ >> 3) * ASTR + (c_ & 7) * 16) = RA[s_]; } } \
        _Pragma("unroll") for (int s_ = 0; s_ < 4; ++s_) *(LAS u32x4*)(Bs + (bk + 16 * s_) * B_STR + bc * 2) = RB[s_]; \
        __syncthreads(); \
        GK_LOAD(RA, RB, ((KT) + 2 < nkt) ? (KT) + 2 : nkt - 1); \
        mma_ktile<ASTR>(acc, a_ptr + (HAS_A ? 0 : (KT) * 128), b_ptr); } while (0)
    GK_LOAD(ra0, rb0, 0);
    GK_LOAD(ra1, rb1, (nkt > 1) ? 1 : 0);
    for (int kt = 0; kt < nkt; kt += 2) {
        GK_STEP(ra0, rb0, kt);
        GK_STEP(ra1, rb1, kt + 1);
    }
#undef GK_LOAD
#undef GK_STEP
}

struct ALoadDense {
    const u16* base; int lda;
    DI u32x4 operator()(int r, int k) const { return *(const u32x4*)(base + (size_t)r * lda + k); }
};
struct ALoadNone { DI u32x4 operator()(int, int) const { return (u32x4){0, 0, 0, 0}; } };
struct BLoadDense {
    const float* W; int ldw; int K; int ncols;
    DI f32x4 operator()(int k, int c) const {
        f32x4 z = {0.f, 0.f, 0.f, 0.f};
        if (k < K && c < ncols) z = *(const f32x4*)(W + (size_t)k * ldw + c);
        return z;
    }
};
struct BLoadDenseU {
    const float* W; int ldw;
    DI f32x4 operator()(int k, int c) const { return *(const f32x4*)(W + (size_t)k * ldw + c); }
};
struct BLoad16U {
    const u16* W; int ldw;
    DI u32x4 operator()(int k, int c) const { return *(const u32x4*)(W + (size_t)k * ldw + c); }
};
struct BLoadDual {
    const float* W0; const float* W1;
    DI f32x4 operator()(int k, int c) const {
        f32x4 z = {0.f, 0.f, 0.f, 0.f};
        if (c < 64) z = *(const f32x4*)(W0 + (size_t)k * 64 + c);
        else if (c < 128) z = *(const f32x4*)(W1 + (size_t)k * 64 + (c - 64));
        return z;
    }
};

struct BLoad16Dense {
    const u16* W; int ldw; int K; int ncols;
    DI u32x4 operator()(int k, int c) const {
        u32x4 z = {0u, 0u, 0u, 0u};
        if (k < K && c < ncols) z = *(const u32x4*)(W + (size_t)k * ldw + c);
        return z;
    }
};
struct RowAll { DI int operator()(int m0) const { return m0; } };
struct RowLat { DI int operator()(int m0) const { return (m0 >> 11) * NTOK + CTXL + (m0 & 2047); } };

constexpr int LDS_A3 = LDS_BASE;
constexpr int LDS_B3 = LDS_A3 + 2 * 128 * A_STR;
constexpr int LDS_T3 = LDS_B3 + 2 * 256 * A_STR;
constexpr int T3_STR = 272, T3_SZ = 16 * T3_STR;
constexpr int LDS_TAB3 = LDS_T3 + 8 * T3_SZ;
static_assert(LDS_TAB3 + 8192 <= LDS_BYTES, "v3 LDS map");
constexpr int LDS_PG8_TAB = LDS_BASE + 8 * 128 * 64 * 2;
static_assert(LDS_PG8_TAB + 8192 <= LDS_BYTES, "pg8 LDS map");
struct BtDesc { const u16* Bt; int ldb, K, N; };
template <class RowMap, class Epi>
DI void gemm_phase(ldsp lds, const u16* A, int lda, int M, const BtDesc bd, const RowMap& rmap, const Epi& epi, int first_ = -1, int stride_ = 0) {
    const int tid = threadIdx.x, lane = tid & 63, wave = tid >> 6, wr = wave >> 2, wc = wave & 3, g = lane >> 4;
    const int G = first_ < 0 ? (int)gridDim.x : stride_;
    const int ntn = (bd.N + 255) >> 8, ntm = M >> 7, nkt = (bd.K + 63) >> 6, ntiles = ntm * ntn;
    const int first = first_ < 0 ? (int)blockIdx.x : first_;
    if (first >= ntiles) return;
    const int S = ((ntiles - first + G - 1) / G) * nkt;
    int l_tile = first, l_kt = 0;
    int c_tile = first, c_kt = 0;
    u32x4 ra0[2], ra1[2], rb0[4], rb1[4];
#define V3_LOAD(RA, RB) do { \
        const int tm_ = l_tile / ntn, tn_ = l_tile - tm_ * ntn; \
        const u16* ab_ = A + (size_t)rmap(tm_ * 128) * lda + l_kt * 64; \
        const u16* bb_ = bd.Bt + (size_t)(tn_ * 256) * bd.ldb + l_kt * 64; \
        _Pragma("unroll") for (int q_ = 0; q_ < 2; ++q_) { const int c_ = tid + 512 * q_; RA[q_] = *(const u32x4*)(ab_ + (size_t)(c_ >> 3) * lda + (c_ & 7) * 8); } \
        _Pragma("unroll") for (int q_ = 0; q_ < 4; ++q_) { const int c_ = tid + 512 * q_; RB[q_] = *(const u32x4*)(bb_ + (size_t)(c_ >> 3) * bd.ldb + (c_ & 7) * 8); } \
        { const int nk_ = l_kt + 1; const bool wrap_ = (nk_ == nkt); const bool more_ = (l_tile + G < ntiles); \
          l_kt = wrap_ ? 0 : nk_; l_tile = (wrap_ && more_) ? l_tile + G : l_tile; } } while (0)
#define V3_WRITE(RA, RB, GS) do { \
        ldsp As_ = lds + LDS_A3 + ((GS) & 1) * (128 * A_STR); ldsp Bs_ = lds + LDS_B3 + ((GS) & 1) * (256 * A_STR); \
        _Pragma("unroll") for (int q_ = 0; q_ < 2; ++q_) { const int c_ = tid + 512 * q_; *(LAS u32x4*)(As_ + (c_ >> 3) * A_STR + (c_ & 7) * 16) = RA[q_]; } \
        _Pragma("unroll") for (int q_ = 0; q_ < 4; ++q_) { const int c_ = tid + 512 * q_; *(LAS u32x4*)(Bs_ + (c_ >> 3) * A_STR + (c_ & 7) * 16) = RB[q_]; } } while (0)
    f32x4 acc[4][4];
#pragma unroll
    for (int i = 0; i < 4; ++i)
#pragma unroll
        for (int j = 0; j < 4; ++j) acc[i][j] = (f32x4){0.f, 0.f, 0.f, 0.f};
#define V3_STEP(RA, RB, GI) do { \
        V3_WRITE(RA, RB, (GI) + 1); \
        V3_LOAD(RA, RB); \
        { \
            const LAS unsigned char* ap_ = lds + LDS_A3 + ((GI) & 1) * (128 * A_STR) + (wr * 64 + (lane & 15)) * A_STR + g * 16; \
            const LAS unsigned char* bp_ = lds + LDS_B3 + ((GI) & 1) * (256 * A_STR) + (wc * 64 + (lane & 15)) * A_STR + g * 16; \
            _Pragma("unroll") for (int ks_ = 0; ks_ < 2; ++ks_) { \
                s16x8 a_[4], b_[4]; \
                _Pragma("unroll") for (int t_ = 0; t_ < 4; ++t_) { a_[t_] = *(const LAS s16x8*)(ap_ + t_ * 16 * A_STR + ks_ * 64); b_[t_] = *(const LAS s16x8*)(bp_ + t_ * 16 * A_STR + ks_ * 64); } \
                _Pragma("unroll") for (int mt_ = 0; mt_ < 4; ++mt_) _Pragma("unroll") for (int nt_ = 0; nt_ < 4; ++nt_) \
                    acc[mt_][nt_] = __builtin_amdgcn_mfma_f32_16x16x32_bf16(a_[mt_], b_[nt_], acc[mt_][nt_], 0, 0, 0); \
            } \
        } \
        if (++c_kt == nkt) { \
            if (c_tile < ntiles) { \
                const int tm_ = c_tile / ntn, tn_ = c_tile - tm_ * ntn; \
                const int mb_ = tm_ * 128 + wr * 64, gb_ = rmap(tm_ * 128) + wr * 64, cb_ = tn_ * 256 + wc * 64; \
                f32x4 cx0_, cx1_; epi.ctx(cb_ + (lane & 7) * 8, cx0_, cx1_);        \
                epi.pre(acc, gb_, cb_, lane); \
                ldsp tb_ = lds + LDS_T3 + wave * T3_SZ; \
                _Pragma("unroll") for (int mt_ = 0; mt_ < 4; ++mt_) { \
                    _Pragma("unroll") for (int nt_ = 0; nt_ < 4; ++nt_) _Pragma("unroll") for (int i_ = 0; i_ < 4; ++i_) \
                        *(LAS float*)(tb_ + (4 * g + i_) * T3_STR + (nt_ * 16 + (lane & 15)) * 4) = acc[mt_][nt_][i_]; \
                    _Pragma("unroll") for (int q_ = 0; q_ < 2; ++q_) { \
                        const int id_ = lane + 64 * q_, r_ = id_ >> 3, ch_ = id_ & 7; \
                        const f32x4 v0_ = *(const LAS f32x4*)(tb_ + r_ * T3_STR + ch_ * 32), v1_ = *(const LAS f32x4*)(tb_ + r_ * T3_STR + ch_ * 32 + 16); \
                        epi.store(mb_ + mt_ * 16 + r_, gb_ + mt_ * 16 + r_, cb_ + ch_ * 8, v0_, v1_, cx0_, cx1_); \
                    } \
                } \
            } \
            _Pragma("unroll") for (int i_ = 0; i_ < 4; ++i_) _Pragma("unroll") for (int j_ = 0; j_ < 4; ++j_) acc[i_][j_] = (f32x4){0.f, 0.f, 0.f, 0.f}; \
            c_kt = 0; c_tile += G; \
        } \
        __syncthreads(); } while (0)
    __syncthreads();
    V3_LOAD(ra0, rb0);
    V3_LOAD(ra1, rb1);
    V3_WRITE(ra0, rb0, 0);
    V3_LOAD(ra0, rb0);
    __syncthreads();
    for (int gi = 0; gi < S; gi += 2) {
        V3_STEP(ra1, rb1, gi);
        V3_STEP(ra0, rb0, gi + 1);
    }
#undef V3_LOAD
#undef V3_WRITE
#undef V3_STEP
}

template <class RowMap, class MakeB, class Epi>
DI void gemm_phase_f32(ldsp lds, const u16* A, int lda, int M, int N, int K, const RowMap& rmap, const MakeB& makeb, const Epi& epi) {
    const int lane = threadIdx.x & 63, wave = threadIdx.x >> 6, wr = wave >> 2, wc = wave & 3;
    const int ntn = (N + 255) >> 8, ntm = M >> 7, nkt = (K + 63) >> 6;
    for (int tile = blockIdx.x; tile < ntm * ntn; tile += gridDim.x) {
        const int tm = tile / ntn, tn = tile - tm * ntn;
        const int grow0 = rmap(tm * 128);
        ALoadDense al{A + (size_t)grow0 * lda, lda};
        auto bl = makeb(tn * 256);
        f32x4 acc[4][4];
#pragma unroll
        for (int i = 0; i < 4; ++i)
#pragma unroll
            for (int j = 0; j < 4; ++j) acc[i][j] = (f32x4){0.f, 0.f, 0.f, 0.f};
        gemm_kloop<true, A_STR>(lds, nkt, al, bl, acc, (const LAS unsigned char*)nullptr);
        epi(acc, tm * 128 + wr * 64, grow0 + wr * 64, tn * 256 + wc * 64, lane);
    }
}
struct MakeBDenseF { const float* W; int ldw, K, N; DI BLoadDenseU operator()(int col0) const { return BLoadDenseU{W + col0, ldw}; } };

#define EPI_LOOP  _Pragma("unroll") for (int mt = 0; mt < 4; ++mt) _Pragma("unroll") for (int nt = 0; nt < 4; ++nt) _Pragma("unroll") for (int i = 0; i < 4; ++i)
#define EPI_ROW(base) ((base) + mt * 16 + (lane >> 4) * 4 + i)
#define EPI_COL (cbase + nt * 16 + (lane & 15))

DI u32x4 pack8(const f32x4& a, const f32x4& b) { return (u32x4){pack2(a[0], a[1]), pack2(a[2], a[3]), pack2(b[0], b[1]), pack2(b[2], b[3])}; }
struct EpiInProj {
    u16* hp; const LAS f32x2* tab;
    DI void pre(f32x4 (&acc)[4][4], int gbase, int cbase, int lane) const {
        const bool rope_blk = (cbase < 640) || (cbase >= 768 && cbase < 1792);
        if (!rope_blk) return;
        const int f = lane & 15;
#pragma unroll
        for (int mt = 0; mt < 4; ++mt)
#pragma unroll
            for (int i = 0; i < 4; ++i) {
                const int row = gbase + mt * 16 + (lane >> 4) * 4 + i;
                const int n = row % NTOK;
                const bool lat = n >= CTXL;
                const int s = lat ? n - CTXL : 0;
                f32x2 cr = tab[(s >> 6) * 16 + f], cc = tab[(s & 63) * 16 + f];
                if (!lat) { cr = (f32x2){1.f, 0.f}; cc = (f32x2){1.f, 0.f}; }
                const float v0 = acc[mt][0][i], v1 = acc[mt][1][i], v2 = acc[mt][2][i], v3 = acc[mt][3][i];
                acc[mt][0][i] = v0 * cr[0] - v1 * cr[1]; acc[mt][1][i] = v1 * cr[0] + v0 * cr[1];
                acc[mt][2][i] = v2 * cc[0] - v3 * cc[1]; acc[mt][3][i] = v3 * cc[0] + v2 * cc[1];
            }
    }
    DI void ctx(int, f32x4& a, f32x4& b) const { a = (f32x4){0.f, 0.f, 0.f, 0.f}; b = a; }
    DI void store(int, int grow, int col, const f32x4& v0, const f32x4& v1, const f32x4&, const f32x4&) const { *(u32x4*)(hp + (size_t)grow * HPW + col) = pack8(v0, v1); }
};
struct EpiResid {
    float* z; const float* h; const float* modbase; int layer;
    DI void ctx(int, f32x4& a, f32x4& b) const { a = (f32x4){0.f, 0.f, 0.f, 0.f}; b = a; }
    DI void pre(f32x4 (&)[4][4], int, int, int) const {}
    DI void store(int, int grow, int col, const f32x4& v0, const f32x4& v1, const f32x4&, const f32x4&) const {
        const int mr = modrow_of(grow);
        const float* m2 = modbase + ((size_t)(layer * 9 + mr) * 6 + 2) * 1024 + col;
        const size_t o = (size_t)grow * D + col;
        const f32x4 h0 = *(const f32x4*)(h + o), h1 = *(const f32x4*)(h + o + 4);
        *(f32x4*)(z + o) = ALPHA * h0 + *(const f32x4*)m2 * v0;
        *(f32x4*)(z + o + 4) = ALPHA * h1 + *(const f32x4*)(m2 + 4) * v1;
    }
};
template <int ACT>
struct EpiBf16 {
    u16* out; int ld; int nvalid;
    DI void ctx(int, f32x4& a, f32x4& b) const { a = (f32x4){0.f, 0.f, 0.f, 0.f}; b = a; }
    DI void pre(f32x4 (&)[4][4], int, int, int) const {}
    DI void store(int, int grow, int col, f32x4 v0, f32x4 v1, const f32x4&, const f32x4&) const {
        if (col >= ld) return;
#pragma unroll
        for (int e = 0; e < 4; ++e) {
            if (ACT == 1) { v0[e] = tanhf(v0[e]); v1[e] = tanhf(v1[e]); }
            else if (ACT == 2) { v0[e] = sigmoidf_(v0[e]); v1[e] = sigmoidf_(v1[e]); }
        }
        if (col >= nvalid) { v0 = (f32x4){0.f, 0.f, 0.f, 0.f}; v1 = v0; }
        *(u32x4*)(out + (size_t)grow * ld + col) = pack8(v0, v1);
    }
};
struct EpiDecay {
    float* out; const float* dec0;
    DI void ctx(int col, f32x4& a, f32x4& b) const { a = *(const f32x4*)(dec0 + col); b = *(const f32x4*)(dec0 + col + 4); }
    DI void pre(f32x4 (&)[4][4], int, int, int) const {}
    DI void store(int, int grow, int col, const f32x4& v0, const f32x4& v1, const f32x4& c0, const f32x4& c1) const {
        f32x4 r0, r1;
#pragma unroll
        for (int e = 0; e < 4; ++e) {
            r0[e] = -0.60653065971263342f * sigmoidf_(c0[e] + v0[e]); r1[e] = -0.60653065971263342f * sigmoidf_(c1[e] + v1[e]);
        }
        *(f32x4*)(out + (size_t)grow * D + col) = r0; *(f32x4*)(out + (size_t)grow * D + col + 4) = r1;
    }
};
struct EpiSigBias {
    u16* out; const float* bias;
    DI void ctx(int col, f32x4& a, f32x4& b) const { a = *(const f32x4*)(bias + col); b = *(const f32x4*)(bias + col + 4); }
    DI void pre(f32x4 (&)[4][4], int, int, int) const {}
    DI void store(int, int grow, int col, f32x4 v0, f32x4 v1, const f32x4& c0, const f32x4& c1) const {
#pragma unroll
        for (int e = 0; e < 4; ++e) { v0[e] = sigmoidf_(c0[e] + v0[e]); v1[e] = sigmoidf_(c1[e] + v1[e]); }
        *(u32x4*)(out + (size_t)grow * D + col) = pack8(v0, v1);
    }
};
struct EpiSigScore {
    float* sc;
    DI void operator()(const f32x4 (&acc)[4][4], int mbase, int, int cbase, int lane) const {
        EPI_LOOP { sc[(size_t)EPI_ROW(mbase) * 256 + EPI_COL] = sigmoidf_(acc[mt][nt][i]); }
    }
};
struct EpiF32 {
    float* out; int ld;
    DI void operator()(const f32x4 (&acc)[4][4], int, int gbase, int cbase, int lane) const {
        EPI_LOOP { out[(size_t)EPI_ROW(gbase) * ld + EPI_COL] = acc[mt][nt][i]; }
    }
};


namespace pg8 {
constexpr int BM = 256, BK = 64, HALF = 128, HTB = HALF * BK * 2, STAGE_BYTES = 8 * HTB, NXCD = 8, WGM = 8;
DI int lds_byte(int r, int c) { const int st = (r >> 4) * 2 + (c >> 5), rr = r & 15, cc = c & 31, ob = rr * 64 + cc * 2; return st * 1024 + (ob ^ (((ob >> 9) & 1) << 5)); }
DI void stage_rc(int b, int& R, int& C) { const int st = b / 1024, sb = b % 1024, swz = sb ^ (((sb >> 9) & 1) << 5); R = (st >> 1) * 16 + swz / 64; C = (st & 1) * 32 + (swz % 64) / 2; }
DI int perm32(int rho) { const int n = rho >> 4, i = rho & 15; return 8 * (i >> 2) + 4 * n + (i & 3); }
struct Unit { int pm, pn, g, rows; };
struct Order {
    int nM, nN, per, total, G, c;
    DI void init(int M, int N, int NG, int G_, int c_) { nM = M / BM; nN = N / BM; per = nM * nN; total = per * NG; G = G_; c = c_; }
    DI bool next(int i, Unit& u) const {
        const int fr = total / G, rem = total - fr * G;
        const bool split = rem > 0 && 2 * rem <= G;
        long L; int half = 3;
        if (!split || i < fr) { L = (long)i * G + c; if (L >= total) return false; }
        else { if (i > fr || c >= 2 * rem) return false; L = (long)fr * G + (c >> 1); half = 1 + (c & 1); }
        u.g = (int)(L / per); int wgid = (int)(L - (long)u.g * per);
        { const int q = per / NXCD, r = per % NXCD, xcd = wgid % NXCD, off = wgid / NXCD; wgid = (xcd < r ? xcd * (q + 1) : r * (q + 1) + (xcd - r) * q) + off; }
        const int nig = WGM * nN, gid = wgid / nig, fm = gid * WGM, gsz = (nM - fm) < WGM ? (nM - fm) : WGM;
        u.pm = fm + ((wgid % nig) % gsz); u.pn = (wgid % nig) / gsz; u.rows = half; return true;
    }
};
template <class Epi, class Addr>
DI void gemm_phase(ldsp lds, int K, const Order& S, const Addr& AD, const Epi& E) {
    const int tid = threadIdx.x, wid = __builtin_amdgcn_readfirstlane(tid >> 6), lane = tid & 63, wr = wid >> 2, wc = wid & 3, fr = lane & 15, fq = lane >> 4;
    const int nt = K / BK;
    unsigned voffA[2], voffB[2];
#pragma unroll
    for (int i = 0; i < 2; ++i) { int R, C; stage_rc(tid * 16 + i * 8192, R, C); const int Rb = Epi::PERM ? ((R & ~31) + perm32(R & 31)) : R;
        voffA[i] = (unsigned)(R * K + C) * 2u; voffB[i] = (unsigned)(Rb * K + C) * 2u; }
    const size_t kstep = (size_t)(BK * 2);
    const size_t hstep = (size_t)HALF * K * 2;
    const unsigned ldsw = (unsigned)wid * 1024u;
    const int aoff = lds_byte(wr * 64 + fr, fq * 8), boff = lds_byte(wc * 32 + fr, fq * 8);
#define PG8_SA(b, h) (((b) * 2 + (h)) * HTB)
#define PG8_SB(b, h) ((4 + (b) * 2 + (h)) * HTB)
#define PG8_STAGE(bufoff, gbase, voff) do { _Pragma("unroll") for (int _i = 0; _i < 2; ++_i) \
        __builtin_amdgcn_global_load_lds((const unsigned*)((const char*)(gbase) + (voff)[_i]), (LAS unsigned*)(lds + (bufoff) + ldsw + _i * 8192), 16, 0, 0); } while (0)
#define PG8_LDA(dst, b, h) do { _Pragma("unroll") for (int m = 0; m < 4; ++m) _Pragma("unroll") for (int k = 0; k < 2; ++k) dst[m][k] = *(const LAS s16x8*)(lds + PG8_SA(b, h) + aoff + m * 2048 + k * 1024); } while (0)
#define PG8_LDB(dst, b, h) do { _Pragma("unroll") for (int n = 0; n < 2; ++n) _Pragma("unroll") for (int k = 0; k < 2; ++k) dst[n][k] = *(const LAS s16x8*)(lds + PG8_SB(b, h) + boff + n * 2048 + k * 1024); } while (0)
#define PG8_MMA(ai, bj, At, Bt) do { __builtin_amdgcn_s_setprio(1); _Pragma("unroll") for (int m = 0; m < 4; ++m) _Pragma("unroll") for (int n = 0; n < 2; ++n) _Pragma("unroll") for (int k = 0; k < 2; ++k) \
        acc[ai][bj][m][n] = __builtin_amdgcn_mfma_f32_16x16x32_bf16(Bt[n][k], At[m][k], acc[ai][bj][m][n], 0, 0, 0); __builtin_amdgcn_s_setprio(0); } while (0)
#define PG8_WAIT_V(n) asm volatile("s_waitcnt vmcnt(" #n ")" ::: "memory")
#define PG8_WAIT_L(n) asm volatile("s_waitcnt lgkmcnt(" #n ")" ::: "memory")
#define PG8_BAR __builtin_amdgcn_s_barrier()
#define PG8_SCHED __builtin_amdgcn_sched_barrier(0)
    Unit cur, nxt; int ui = 0;
    if (!S.next(0, cur)) return;
    f32x4 acc[2][2][4][2];
#pragma unroll
    for (int a = 0; a < 2; ++a)
#pragma unroll
        for (int b = 0; b < 2; ++b)
#pragma unroll
            for (int m = 0; m < 4; ++m)
#pragma unroll
                for (int n = 0; n < 2; ++n) acc[a][b][m][n] = (f32x4){0.f, 0.f, 0.f, 0.f};
    s16x8 At[4][2], B0[2][2], B1[2][2];
    const char* cA = AD.a(cur); const char* cB = AD.b(cur);
    PG8_STAGE(PG8_SB(0, 0), cB, voffB); PG8_STAGE(PG8_SA(0, 0), cA, voffA); PG8_STAGE(PG8_SB(0, 1), cB + hstep, voffB); PG8_STAGE(PG8_SA(0, 1), cA + hstep, voffA);
    if (wr == 1) PG8_BAR;
    PG8_WAIT_V(4); PG8_BAR;
    PG8_STAGE(PG8_SB(1, 0), cB + kstep, voffB); PG8_STAGE(PG8_SA(1, 0), cA + kstep, voffA); PG8_STAGE(PG8_SB(1, 1), cB + hstep + kstep, voffB);
    PG8_WAIT_V(6); PG8_BAR;
    for (;;) {
        const bool has_next = S.next(ui + 1, nxt);
        const char* nA = has_next ? AD.a(nxt) : cA; const char* nB = has_next ? AD.b(nxt) : cB;
        const bool lo_ = (cur.rows & 1) != 0, hi_ = (cur.rows & 2) != 0;
        for (int t = 0; t < nt; t += 2) {
            const bool last = (t == nt - 2);
            const char* a1 = cA + (size_t)(t + 1) * kstep;
            const char* a2 = last ? nA : cA + (size_t)(t + 2) * kstep; const char* b2 = last ? nB : cB + (size_t)(t + 2) * kstep;
            const char* a3 = a2 + kstep; const char* b3 = b2 + kstep;
            PG8_LDB(B0, 0, 0); PG8_SCHED; if (lo_) PG8_LDA(At, 0, 0); PG8_STAGE(PG8_SA(1, 1), a1 + hstep, voffA);
            PG8_WAIT_L(8); PG8_BAR; PG8_WAIT_L(0); if (lo_) PG8_MMA(0, 0, At, B0); PG8_BAR; PG8_SCHED;
            PG8_LDB(B1, 0, 1); PG8_STAGE(PG8_SB(0, 0), b2, voffB);
            PG8_BAR; PG8_WAIT_L(0); if (lo_) PG8_MMA(0, 1, At, B1); PG8_BAR;
            if (hi_) PG8_LDA(At, 0, 1); PG8_STAGE(PG8_SA(0, 0), a2, voffA);
            PG8_BAR; PG8_WAIT_L(0); if (hi_) PG8_MMA(1, 0, At, B0); PG8_BAR; PG8_SCHED;
            PG8_STAGE(PG8_SB(0, 1), b2 + hstep, voffB);
            PG8_WAIT_V(6); PG8_BAR; if (hi_) PG8_MMA(1, 1, At, B1); PG8_BAR;
            PG8_LDB(B0, 1, 0); PG8_SCHED; if (lo_) PG8_LDA(At, 1, 0); PG8_STAGE(PG8_SA(0, 1), a2 + hstep, voffA);
            PG8_WAIT_L(8); PG8_BAR; PG8_WAIT_L(0); if (lo_) PG8_MMA(0, 0, At, B0); PG8_BAR; PG8_SCHED;
            PG8_LDB(B1, 1, 1); PG8_STAGE(PG8_SB(1, 0), b3, voffB);
            PG8_BAR; PG8_WAIT_L(0); if (lo_) PG8_MMA(0, 1, At, B1); PG8_BAR;
            if (hi_) PG8_LDA(At, 1, 1); PG8_STAGE(PG8_SA(1, 0), a3, voffA);
            PG8_BAR; PG8_WAIT_L(0); if (hi_) PG8_MMA(1, 0, At, B0); PG8_BAR; PG8_SCHED;
            PG8_STAGE(PG8_SB(1, 1), b3 + hstep, voffB);
            PG8_WAIT_V(6); PG8_BAR; if (hi_) PG8_MMA(1, 1, At, B1); PG8_BAR;
        }
        E(acc, cur, wr, wc, fr, fq);
        if (!has_next) break;
#pragma unroll
        for (int a = 0; a < 2; ++a)
#pragma unroll
            for (int b = 0; b < 2; ++b)
#pragma unroll
                for (int m = 0; m < 4; ++m)
#pragma unroll
                    for (int n = 0; n < 2; ++n) acc[a][b][m][n] = (f32x4){0.f, 0.f, 0.f, 0.f};
        cur = nxt; cA = nA; cB = nB; ++ui;
    }
    PG8_WAIT_V(0);
    if (wr == 0) PG8_BAR;
    PG8_BAR;
#undef PG8_SA
#undef PG8_SB
#undef PG8_STAGE
#undef PG8_LDA
#undef PG8_LDB
#undef PG8_MMA
#undef PG8_WAIT_V
#undef PG8_WAIT_L
#undef PG8_BAR
#undef PG8_SCHED
}

template <class Epi, class Sched, class Addr>
DI void gemm_phase_gather(ldsp lds, int K, const Sched& S, const Addr& AD, const Epi& E) {
    int tid_ = threadIdx.x; asm volatile("" : "+v"(tid_));
    const int tid = tid_, wid = __builtin_amdgcn_readfirstlane(tid >> 6), lane = tid & 63, wr = wid >> 2, wc = wid & 3, fr = lane & 15, fq = lane >> 4;
    const int nt = K / BK;
    unsigned voffB[2]; int stR[2], stC[2];
#pragma unroll
    for (int i = 0; i < 2; ++i) { int R, C; stage_rc(tid * 16 + i * 8192, R, C); const int Rb = Epi::PERM ? ((R & ~31) + perm32(R & 31)) : R;
        stR[i] = R; stC[i] = C; voffB[i] = (unsigned)(Rb * BK + C) * 2u;          }
    unsigned cv0[2], cv1[2], nv0[2], nv1[2];
#define PG8_GOFF(v0, v1, u) do { _Pragma("unroll") for (int _i = 0; _i < 2; ++_i) { \
        v0[_i] = ((unsigned)AD.arow(u, stR[_i]) * (unsigned)K + (unsigned)stC[_i]) * 2u; v1[_i] = ((unsigned)AD.arow(u, HALF + stR[_i]) * (unsigned)K + (unsigned)stC[_i]) * 2u; } } while (0)
    const size_t kstep = (size_t)(BK * 2);
    const size_t hstep = (size_t)HALF * K * 2;
    const size_t kstepB = (size_t)BM * BK * 2, hstepB = (size_t)HALF * BK * 2;
    const unsigned ldsw = (unsigned)wid * 1024u;
    const int aoff = lds_byte(wr * 64 + fr, fq * 8), boff = lds_byte(wc * 32 + fr, fq * 8);
#define PG8_SA(b, h) (((b) * 2 + (h)) * HTB)
#define PG8_SB(b, h) ((4 + (b) * 2 + (h)) * HTB)
#define PG8_STAGE(bufoff, gbase, voff) do { _Pragma("unroll") for (int _i = 0; _i < 2; ++_i) \
        __builtin_amdgcn_global_load_lds((const unsigned*)((const char*)(gbase) + (voff)[_i]), (LAS unsigned*)(lds + (bufoff) + ldsw + _i * 8192), 16, 0, 0); } while (0)
#define PG8_LDA(dst, b, h) do { _Pragma("unroll") for (int m = 0; m < 4; ++m) _Pragma("unroll") for (int k = 0; k < 2; ++k) dst[m][k] = *(const LAS s16x8*)(lds + PG8_SA(b, h) + aoff + m * 2048 + k * 1024); } while (0)
#define PG8_LDB(dst, b, h) do { _Pragma("unroll") for (int n = 0; n < 2; ++n) _Pragma("unroll") for (int k = 0; k < 2; ++k) dst[n][k] = *(const LAS s16x8*)(lds + PG8_SB(b, h) + boff + n * 2048 + k * 1024); } while (0)
#define PG8_MMA(ai, bj, At, Bt) do { __builtin_amdgcn_s_setprio(1); _Pragma("unroll") for (int m = 0; m < 4; ++m) _Pragma("unroll") for (int n = 0; n < 2; ++n) _Pragma("unroll") for (int k = 0; k < 2; ++k) \
        acc[ai][bj][m][n] = __builtin_amdgcn_mfma_f32_16x16x32_bf16(Bt[n][k], At[m][k], acc[ai][bj][m][n], 0, 0, 0); __builtin_amdgcn_s_setprio(0); } while (0)
#define PG8_WAIT_V(n) asm volatile("s_waitcnt vmcnt(" #n ")" ::: "memory")
#define PG8_WAIT_L(n) asm volatile("s_waitcnt lgkmcnt(" #n ")" ::: "memory")
#define PG8_BAR __builtin_amdgcn_s_barrier()
#define PG8_SCHED __builtin_amdgcn_sched_barrier(0)
    Unit cur, nxt; int ui = 0;
    if (!S.next(0, cur)) return;
    f32x4 acc[2][2][4][2];
#pragma unroll
    for (int a = 0; a < 2; ++a)
#pragma unroll
        for (int b = 0; b < 2; ++b)
#pragma unroll
            for (int m = 0; m < 4; ++m)
#pragma unroll
                for (int n = 0; n < 2; ++n) acc[a][b][m][n] = (f32x4){0.f, 0.f, 0.f, 0.f};
    s16x8 At[4][2], B0[2][2], B1[2][2];
    const char* cA = AD.a0(); const char* cB = AD.b(cur);
    PG8_GOFF(cv0, cv1, cur);
    PG8_STAGE(PG8_SB(0, 0), cB, voffB); PG8_STAGE(PG8_SA(0, 0), cA, cv0); PG8_STAGE(PG8_SB(0, 1), cB + hstepB, voffB); PG8_STAGE(PG8_SA(0, 1), cA, cv1);
    if (wr == 1) PG8_BAR;
    PG8_WAIT_V(4); PG8_BAR;
    PG8_STAGE(PG8_SB(1, 0), cB + kstepB, voffB); PG8_STAGE(PG8_SA(1, 0), cA + kstep, cv0); PG8_STAGE(PG8_SB(1, 1), cB + hstepB + kstepB, voffB);
    PG8_WAIT_V(6); PG8_BAR;
    for (;;) {
        const bool has_next = S.next(ui + 1, nxt);
        const char* nB = has_next ? AD.b(nxt) : cB;
        if (has_next) PG8_GOFF(nv0, nv1, nxt); else { nv0[0] = cv0[0]; nv0[1] = cv0[1]; nv1[0] = cv1[0]; nv1[1] = cv1[1]; }
        const bool lo_ = (cur.rows & 1) != 0, hi_ = (cur.rows & 2) != 0;
        for (int t = 0; t < nt; t += 2) {
            const bool last = (t == nt - 2);
            const char* a1 = cA + (size_t)(t + 1) * kstep;
            const char* a2 = last ? cA : cA + (size_t)(t + 2) * kstep; const char* b2 = last ? nB : cB + (size_t)(t + 2) * kstepB;
            unsigned w0[2], w1[2]; w0[0] = last ? nv0[0] : cv0[0]; w0[1] = last ? nv0[1] : cv0[1]; w1[0] = last ? nv1[0] : cv1[0]; w1[1] = last ? nv1[1] : cv1[1];
            const char* a3 = a2 + kstep; const char* b3 = b2 + kstepB;
            PG8_LDB(B0, 0, 0); PG8_SCHED; if (lo_) PG8_LDA(At, 0, 0); PG8_STAGE(PG8_SA(1, 1), a1, cv1);
            PG8_WAIT_L(8); PG8_BAR; PG8_WAIT_L(0); if (lo_) PG8_MMA(0, 0, At, B0); PG8_BAR; PG8_SCHED;
            PG8_LDB(B1, 0, 1); PG8_STAGE(PG8_SB(0, 0), b2, voffB);
            PG8_BAR; PG8_WAIT_L(0); if (lo_) PG8_MMA(0, 1, At, B1); PG8_BAR;
            if (hi_) PG8_LDA(At, 0, 1); PG8_STAGE(PG8_SA(0, 0), a2, w0);
            PG8_BAR; PG8_WAIT_L(0); if (hi_) PG8_MMA(1, 0, At, B0); PG8_BAR; PG8_SCHED;
            PG8_STAGE(PG8_SB(0, 1), b2 + hstepB, voffB);
            PG8_WAIT_V(6); PG8_BAR; if (hi_) PG8_MMA(1, 1, At, B1); PG8_BAR;
            PG8_LDB(B0, 1, 0); PG8_SCHED; if (lo_) PG8_LDA(At, 1, 0); PG8_STAGE(PG8_SA(0, 1), a2, w1);
            PG8_WAIT_L(8); PG8_BAR; PG8_WAIT_L(0); if (lo_) PG8_MMA(0, 0, At, B0); PG8_BAR; PG8_SCHED;
            PG8_LDB(B1, 1, 1); PG8_STAGE(PG8_SB(1, 0), b3, voffB);
            PG8_BAR; PG8_WAIT_L(0); if (lo_) PG8_MMA(0, 1, At, B1); PG8_BAR;
            if (hi_) PG8_LDA(At, 1, 1); PG8_STAGE(PG8_SA(1, 0), a3, w0);
            PG8_BAR; PG8_WAIT_L(0); if (hi_) PG8_MMA(1, 0, At, B0); PG8_BAR; PG8_SCHED;
            PG8_STAGE(PG8_SB(1, 1), b3 + hstepB, voffB);
            PG8_WAIT_V(6); PG8_BAR; if (hi_) PG8_MMA(1, 1, At, B1); PG8_BAR;
        }
        E(acc, cur, wr, wc, fr, fq);
        if (!has_next) break;
#pragma unroll
        for (int a = 0; a < 2; ++a)
#pragma unroll
            for (int b = 0; b < 2; ++b)
#pragma unroll
                for (int m = 0; m < 4; ++m)
#pragma unroll
                    for (int n = 0; n < 2; ++n) acc[a][b][m][n] = (f32x4){0.f, 0.f, 0.f, 0.f};
        cur = nxt; cB = nB; ++ui; cv0[0] = nv0[0]; cv0[1] = nv0[1]; cv1[0] = nv1[0]; cv1[1] = nv1[1];
    }
    PG8_WAIT_V(0);
    if (wr == 0) PG8_BAR;
    PG8_BAR;
#undef PG8_GOFF
#undef PG8_SA
#undef PG8_SB
#undef PG8_STAGE
#undef PG8_LDA
#undef PG8_LDB
#undef PG8_MMA
#undef PG8_WAIT_V
#undef PG8_WAIT_L
#undef PG8_BAR
#undef PG8_SCHED
}


template <class Epi, class Sched, class Addr>
DI void gemm_phase_s(ldsp lds, int K, const Sched& S, const Addr& AD, const Epi& E) {
    int tid_ = threadIdx.x; asm volatile("" : "+v"(tid_));
    const int tid = tid_, wid = __builtin_amdgcn_readfirstlane(tid >> 6), lane = tid & 63, wr = wid >> 2, wc = wid & 3, fr = lane & 15, fq = lane >> 4;
    const int nt = K / BK;
    unsigned voffA[2], voffB[2];
#pragma unroll
    for (int i = 0; i < 2; ++i) { int R, C; stage_rc(tid * 16 + i * 8192, R, C); const int Rb = Epi::PERM ? ((R & ~31) + perm32(R & 31)) : R;
        voffA[i] = (unsigned)(R * K + C) * 2u; voffB[i] = (unsigned)(Rb * K + C) * 2u; }
    const size_t kstep = (size_t)(BK * 2);
    const size_t hstep = (size_t)HALF * K * 2;
    const unsigned ldsw = (unsigned)wid * 1024u;
    const int aoff = lds_byte(wr * 64 + fr, fq * 8), boff = lds_byte(wc * 32 + fr, fq * 8);
#define PG8_SA(b, h) (((b) * 2 + (h)) * HTB)
#define PG8_SB(b, h) ((4 + (b) * 2 + (h)) * HTB)
#define PG8_STAGE(bufoff, gbase, voff) do { _Pragma("unroll") for (int _i = 0; _i < 2; ++_i) \
        __builtin_amdgcn_global_load_lds((const unsigned*)((const char*)(gbase) + (voff)[_i]), (LAS unsigned*)(lds + (bufoff) + ldsw + _i * 8192), 16, 0, 0); } while (0)
#define PG8_LDA(dst, b, h) do { _Pragma("unroll") for (int m = 0; m < 4; ++m) _Pragma("unroll") for (int k = 0; k < 2; ++k) dst[m][k] = *(const LAS s16x8*)(lds + PG8_SA(b, h) + aoff + m * 2048 + k * 1024); } while (0)
#define PG8_LDB(dst, b, h) do { _Pragma("unroll") for (int n = 0; n < 2; ++n) _Pragma("unroll") for (int k = 0; k < 2; ++k) dst[n][k] = *(const LAS s16x8*)(lds + PG8_SB(b, h) + boff + n * 2048 + k * 1024); } while (0)
#define PG8_MMA(ai, bj, At, Bt) do { __builtin_amdgcn_s_setprio(1); _Pragma("unroll") for (int m = 0; m < 4; ++m) _Pragma("unroll") for (int n = 0; n < 2; ++n) _Pragma("unroll") for (int k = 0; k < 2; ++k) \
        acc[ai][bj][m][n] = __builtin_amdgcn_mfma_f32_16x16x32_bf16(Bt[n][k], At[m][k], acc[ai][bj][m][n], 0, 0, 0); __builtin_amdgcn_s_setprio(0); } while (0)
#define PG8_WAIT_V(n) asm volatile("s_waitcnt vmcnt(" #n ")" ::: "memory")
#define PG8_WAIT_L(n) asm volatile("s_waitcnt lgkmcnt(" #n ")" ::: "memory")
#define PG8_BAR __builtin_amdgcn_s_barrier()
#define PG8_SCHED __builtin_amdgcn_sched_barrier(0)
    Unit cur, nxt; int ui = 0;
    if (!S.next(0, cur)) return;
    f32x4 acc[2][2][4][2];
#pragma unroll
    for (int a = 0; a < 2; ++a)
#pragma unroll
        for (int b = 0; b < 2; ++b)
#pragma unroll
            for (int m = 0; m < 4; ++m)
#pragma unroll
                for (int n = 0; n < 2; ++n) acc[a][b][m][n] = (f32x4){0.f, 0.f, 0.f, 0.f};
    s16x8 At[4][2], B0[2][2], B1[2][2];
    const char* cA = AD.a(cur); const char* cB = AD.b(cur);
    PG8_STAGE(PG8_SB(0, 0), cB, voffB); PG8_STAGE(PG8_SA(0, 0), cA, voffA); PG8_STAGE(PG8_SB(0, 1), cB + hstep, voffB); PG8_STAGE(PG8_SA(0, 1), cA + hstep, voffA);
    if (wr == 1) PG8_BAR;
    PG8_WAIT_V(4); PG8_BAR;
    PG8_STAGE(PG8_SB(1, 0), cB + kstep, voffB); PG8_STAGE(PG8_SA(1, 0), cA + kstep, voffA); PG8_STAGE(PG8_SB(1, 1), cB + hstep + kstep, voffB);
    PG8_WAIT_V(6); PG8_BAR;
    for (;;) {
        const bool has_next = S.next(ui + 1, nxt);
        const char* nA = has_next ? AD.a(nxt) : cA; const char* nB = has_next ? AD.b(nxt) : cB;
#pragma unroll 1
        for (int t = 0; t < nt; t += 2) {
            const bool last = (t == nt - 2);
            const char* a1 = cA + (size_t)(t + 1) * kstep;
            const char* a2 = last ? nA : cA + (size_t)(t + 2) * kstep; const char* b2 = last ? nB : cB + (size_t)(t + 2) * kstep;
            const char* a3 = a2 + kstep; const char* b3 = b2 + kstep;
            PG8_LDB(B0, 0, 0); PG8_SCHED; PG8_LDA(At, 0, 0); PG8_STAGE(PG8_SA(1, 1), a1 + hstep, voffA);
            PG8_WAIT_L(8); PG8_BAR; PG8_WAIT_L(0); PG8_MMA(0, 0, At, B0); PG8_BAR; PG8_SCHED;
            PG8_LDB(B1, 0, 1); PG8_STAGE(PG8_SB(0, 0), b2, voffB);
            PG8_BAR; PG8_WAIT_L(0); PG8_MMA(0, 1, At, B1); PG8_BAR;
            PG8_LDA(At, 0, 1); PG8_STAGE(PG8_SA(0, 0), a2, voffA);
            PG8_BAR; PG8_WAIT_L(0); PG8_MMA(1, 0, At, B0); PG8_BAR; PG8_SCHED;
            PG8_STAGE(PG8_SB(0, 1), b2 + hstep, voffB);
            PG8_WAIT_V(6); PG8_BAR; PG8_MMA(1, 1, At, B1); PG8_BAR;
            PG8_LDB(B0, 1, 0); PG8_SCHED; PG8_LDA(At, 1, 0); PG8_STAGE(PG8_SA(0, 1), a2 + hstep, voffA);
            PG8_WAIT_L(8); PG8_BAR; PG8_WAIT_L(0); PG8_MMA(0, 0, At, B0); PG8_BAR; PG8_SCHED;
            PG8_LDB(B1, 1, 1); PG8_STAGE(PG8_SB(1, 0), b3, voffB);
            PG8_BAR; PG8_WAIT_L(0); PG8_MMA(0, 1, At, B1); PG8_BAR;
            PG8_LDA(At, 1, 1); PG8_STAGE(PG8_SA(1, 0), a3, voffA);
            PG8_BAR; PG8_WAIT_L(0); PG8_MMA(1, 0, At, B0); PG8_BAR; PG8_SCHED;
            PG8_STAGE(PG8_SB(1, 1), b3 + hstep, voffB);
            PG8_WAIT_V(6); PG8_BAR; PG8_MMA(1, 1, At, B1); PG8_BAR;
        }
        E(acc, cur, wr, wc, fr, fq);
        if (!has_next) break;
#pragma unroll
        for (int a = 0; a < 2; ++a)
#pragma unroll
            for (int b = 0; b < 2; ++b)
#pragma unroll
                for (int m = 0; m < 4; ++m)
#pragma unroll
                    for (int n = 0; n < 2; ++n) acc[a][b][m][n] = (f32x4){0.f, 0.f, 0.f, 0.f};
        cur = nxt; cA = nA; cB = nB; ++ui;
    }
    PG8_WAIT_V(0);
    if (wr == 0) PG8_BAR;
    PG8_BAR;
#undef PG8_SA
#undef PG8_SB
#undef PG8_STAGE
#undef PG8_LDA
#undef PG8_LDB
#undef PG8_MMA
#undef PG8_WAIT_V
#undef PG8_WAIT_L
#undef PG8_BAR
#undef PG8_SCHED
}


template <class Epi, class Sched, class Addr>
DI void gemm_phase_st(ldsp lds, int K, const Sched& S, const Addr& AD, const Epi& E) {
    int tid_ = threadIdx.x; asm volatile("" : "+v"(tid_));
    const int tid = tid_, wid = __builtin_amdgcn_readfirstlane(tid >> 6), lane = tid & 63, wr = wid >> 2, wc = wid & 3, fr = lane & 15, fq = lane >> 4;
    const int nt = K / BK;
    unsigned voffA[2], voffB[2];
#pragma unroll
    for (int i = 0; i < 2; ++i) { int R, C; stage_rc(tid * 16 + i * 8192, R, C); const int Rb = Epi::PERM ? ((R & ~31) + perm32(R & 31)) : R;
        voffA[i] = (unsigned)(R * K + C) * 2u; voffB[i] = (unsigned)(Rb * BK + C) * 2u;          }
    const size_t kstep = (size_t)(BK * 2);
    const size_t hstep = (size_t)HALF * K * 2;
    const size_t kstepB = (size_t)BM * BK * 2, hstepB = (size_t)HALF * BK * 2;
    const unsigned ldsw = (unsigned)wid * 1024u;
    const int aoff = lds_byte(wr * 64 + fr, fq * 8), boff = lds_byte(wc * 32 + fr, fq * 8);
#define PG8_SA(b, h) (((b) * 2 + (h)) * HTB)
#define PG8_SB(b, h) ((4 + (b) * 2 + (h)) * HTB)
#define PG8_STAGE(bufoff, gbase, voff) do { _Pragma("unroll") for (int _i = 0; _i < 2; ++_i) \
        __builtin_amdgcn_global_load_lds((const unsigned*)((const char*)(gbase) + (voff)[_i]), (LAS unsigned*)(lds + (bufoff) + ldsw + _i * 8192), 16, 0, 0); } while (0)
#define PG8_LDA(dst, b, h) do { _Pragma("unroll") for (int m = 0; m < 4; ++m) _Pragma("unroll") for (int k = 0; k < 2; ++k) dst[m][k] = *(const LAS s16x8*)(lds + PG8_SA(b, h) + aoff + m * 2048 + k * 1024); } while (0)
#define PG8_LDB(dst, b, h) do { _Pragma("unroll") for (int n = 0; n < 2; ++n) _Pragma("unroll") for (int k = 0; k < 2; ++k) dst[n][k] = *(const LAS s16x8*)(lds + PG8_SB(b, h) + boff + n * 2048 + k * 1024); } while (0)
#define PG8_MMA(ai, bj, At, Bt) do { __builtin_amdgcn_s_setprio(1); _Pragma("unroll") for (int m = 0; m < 4; ++m) _Pragma("unroll") for (int n = 0; n < 2; ++n) _Pragma("unroll") for (int k = 0; k < 2; ++k) \
        acc[ai][bj][m][n] = __builtin_amdgcn_mfma_f32_16x16x32_bf16(Bt[n][k], At[m][k], acc[ai][bj][m][n], 0, 0, 0); __builtin_amdgcn_s_setprio(0); } while (0)
#define PG8_WAIT_V(n) asm volatile("s_waitcnt vmcnt(" #n ")" ::: "memory")
#define PG8_WAIT_L(n) asm volatile("s_waitcnt lgkmcnt(" #n ")" ::: "memory")
#define PG8_BAR __builtin_amdgcn_s_barrier()
#define PG8_SCHED __builtin_amdgcn_sched_barrier(0)
    Unit cur, nxt; int ui = 0;
    if (!S.next(0, cur)) return;
    f32x4 acc[2][2][4][2];
#pragma unroll
    for (int a = 0; a < 2; ++a)
#pragma unroll
        for (int b = 0; b < 2; ++b)
#pragma unroll
            for (int m = 0; m < 4; ++m)
#pragma unroll
                for (int n = 0; n < 2; ++n) acc[a][b][m][n] = (f32x4){0.f, 0.f, 0.f, 0.f};
    s16x8 At[4][2], B0[2][2], B1[2][2];
    { const typename Epi::Pre q0 = E.prefetch(cur); E.commit(q0, 0); }
    const char* cA = AD.a(cur); const char* cB = AD.b(cur);
    PG8_STAGE(PG8_SB(0, 0), cB, voffB); PG8_STAGE(PG8_SA(0, 0), cA, voffA); PG8_STAGE(PG8_SB(0, 1), cB + hstepB, voffB); PG8_STAGE(PG8_SA(0, 1), cA + hstep, voffA);
    if (wr == 1) PG8_BAR;
    PG8_WAIT_V(4); PG8_BAR;
    PG8_STAGE(PG8_SB(1, 0), cB + kstepB, voffB); PG8_STAGE(PG8_SA(1, 0), cA + kstep, voffA); PG8_STAGE(PG8_SB(1, 1), cB + hstepB + kstepB, voffB);
    PG8_WAIT_V(6); PG8_BAR;
    for (;;) {
        const bool has_next = S.next(ui + 1, nxt);
        const char* nA = has_next ? AD.a(nxt) : cA; const char* nB = has_next ? AD.b(nxt) : cB;
        const bool lo_ = (cur.rows & 1) != 0, hi_ = (cur.rows & 2) != 0;
#pragma unroll 1
        for (int t = 0; t < nt; t += 2) {
            const bool last = (t == nt - 2);
            const char* a1 = cA + (size_t)(t + 1) * kstep;
            const char* a2 = last ? nA : cA + (size_t)(t + 2) * kstep; const char* b2 = last ? nB : cB + (size_t)(t + 2) * kstepB;
            const char* a3 = a2 + kstep; const char* b3 = b2 + kstepB;
            PG8_LDB(B0, 0, 0); PG8_SCHED; if (lo_) PG8_LDA(At, 0, 0); PG8_STAGE(PG8_SA(1, 1), a1 + hstep, voffA);
            PG8_WAIT_L(8); PG8_BAR; PG8_WAIT_L(0); if (lo_) PG8_MMA(0, 0, At, B0); PG8_BAR; PG8_SCHED;
            PG8_LDB(B1, 0, 1); PG8_STAGE(PG8_SB(0, 0), b2, voffB);
            PG8_BAR; PG8_WAIT_L(0); if (lo_) PG8_MMA(0, 1, At, B1); PG8_BAR;
            if (hi_) PG8_LDA(At, 0, 1); PG8_STAGE(PG8_SA(0, 0), a2, voffA);
            PG8_BAR; PG8_WAIT_L(0); if (hi_) PG8_MMA(1, 0, At, B0); PG8_BAR; PG8_SCHED;
            PG8_STAGE(PG8_SB(0, 1), b2 + hstepB, voffB);
            PG8_WAIT_V(6); PG8_BAR; if (hi_) PG8_MMA(1, 1, At, B1); PG8_BAR;
            PG8_LDB(B0, 1, 0); PG8_SCHED; if (lo_) PG8_LDA(At, 1, 0); PG8_STAGE(PG8_SA(0, 1), a2 + hstep, voffA);
            PG8_WAIT_L(8); PG8_BAR; PG8_WAIT_L(0); if (lo_) PG8_MMA(0, 0, At, B0); PG8_BAR; PG8_SCHED;
            PG8_LDB(B1, 1, 1); PG8_STAGE(PG8_SB(1, 0), b3, voffB);
            PG8_BAR; PG8_WAIT_L(0); if (lo_) PG8_MMA(0, 1, At, B1); PG8_BAR;
            if (hi_) PG8_LDA(At, 1, 1); PG8_STAGE(PG8_SA(1, 0), a3, voffA);
            PG8_BAR; PG8_WAIT_L(0); if (hi_) PG8_MMA(1, 0, At, B0); PG8_BAR; PG8_SCHED;
            PG8_STAGE(PG8_SB(1, 1), b3 + hstepB, voffB);
            PG8_WAIT_V(6); PG8_BAR; if (hi_) PG8_MMA(1, 1, At, B1); PG8_BAR;
        }
        const typename Epi::Pre qn = E.prefetch(has_next ? nxt : cur);
        E(acc, cur, wr, wc, fr, fq, ui & 1);
        E.commit(qn, (ui + 1) & 1);
        if (!has_next) break;
#pragma unroll
        for (int a = 0; a < 2; ++a)
#pragma unroll
            for (int b = 0; b < 2; ++b)
#pragma unroll
                for (int m = 0; m < 4; ++m)
#pragma unroll
                    for (int n = 0; n < 2; ++n) acc[a][b][m][n] = (f32x4){0.f, 0.f, 0.f, 0.f};
        cur = nxt; cA = nA; cB = nB; ++ui;
    }
    PG8_WAIT_V(0);
    if (wr == 0) PG8_BAR;
    PG8_BAR;
#undef PG8_SA
#undef PG8_SB
#undef PG8_STAGE
#undef PG8_LDA
#undef PG8_LDB
#undef PG8_MMA
#undef PG8_WAIT_V
#undef PG8_WAIT_L
#undef PG8_BAR
#undef PG8_SCHED
}


struct AddrOne {
    const u16* A; const u16* Bt; int K; bool lat;
    DI const char* a(const Unit& u) const { const int m0 = u.pm * BM; const int r0 = lat ? ((m0 >> 11) * NTOK + CTXL + (m0 & 2047)) : m0; return (const char*)(A + (size_t)r0 * K); }
    DI const char* b(const Unit& u) const { return (const char*)(Bt + (size_t)u.pn * BM * K); }
};
struct AddrThree {
    const u16* A; const u16* Bt;
    DI const char* a(const Unit& u) const { const int mi = u.g + (u.g > 0 ? 1 : 0); return (const char*)(A + ((size_t)mi * T + (size_t)u.pm * BM) * D); }
    DI const char* b(const Unit& u) const { return (const char*)(Bt + ((size_t)u.g * D + (size_t)u.pn * BM) * D); }
};
struct EpiBf16P {
    static constexpr bool PERM = true;
    u16* out; int ld; size_t gstride;
    DI void operator()(const f32x4 (&acc)[2][2][4][2], const Unit& u, int wr, int wc, int fr, int fq) const {
        u16* base = out + (size_t)u.g * gstride;
        const int row0 = u.pm * BM + wr * 64 + fr, col0 = u.pn * BM + wc * 32 + 8 * fq;
#pragma unroll
        for (int ai = 0; ai < 2; ++ai) {
            if (!((u.rows >> ai) & 1)) continue;
#pragma unroll
            for (int m = 0; m < 4; ++m) { u16* rowp = base + (size_t)(row0 + ai * HALF + m * 16) * ld + col0;
#pragma unroll
                for (int bj = 0; bj < 2; ++bj) *(u32x4*)(rowp + bj * HALF) = pack8(acc[ai][bj][m][0], acc[ai][bj][m][1]); }
        }
    }
};
struct EpiInProjP {
    static constexpr bool PERM = true;
    u16* hp; const LAS f32x2* tab;
    DI void operator()(const f32x4 (&acc)[2][2][4][2], const Unit& u, int wr, int wc, int fr, int fq) const {
        const int row0 = u.pm * BM + wr * 64 + fr;
        const bool hi = fq >= 2;
        const int fbase = 8 * (fq & 1);
#pragma unroll
        for (int bj = 0; bj < 2; ++bj) {
            const int cblk = u.pn * BM + bj * HALF + wc * 32;
            const int c64 = cblk & ~63;
            const bool rope_blk = (c64 < 640) || (c64 >= 768 && c64 < 1792);
            const bool colhalf = (cblk & 32) != 0;
#pragma unroll
            for (int ai = 0; ai < 2; ++ai) {
                if (!((u.rows >> ai) & 1)) continue;
#pragma unroll
                for (int m = 0; m < 4; ++m) {
                    const int row = row0 + ai * HALF + m * 16;
                    const int n = row % NTOK; const bool lat = n >= CTXL; const int s = lat ? n - CTXL : 0;
                    const int pos = colhalf ? (s & 63) : (s >> 6);
                    f32x4 v0 = acc[ai][bj][m][0], v1 = acc[ai][bj][m][1];
                    if (rope_blk) {
#pragma unroll
                        for (int j = 0; j < 4; ++j) {
                            const float p0 = __shfl_xor(v0[j], 32), p1 = __shfl_xor(v1[j], 32);
                            f32x2 c0 = tab[pos * 16 + fbase + j], c1 = tab[pos * 16 + fbase + 4 + j];
                            if (!lat) { c0 = (f32x2){1.f, 0.f}; c1 = (f32x2){1.f, 0.f}; }
                            v0[j] = hi ? (v0[j] * c0[0] + p0 * c0[1]) : (v0[j] * c0[0] - p0 * c0[1]);
                            v1[j] = hi ? (v1[j] * c1[0] + p1 * c1[1]) : (v1[j] * c1[0] - p1 * c1[1]);
                        }
                    }
                    *(u32x4*)(hp + (size_t)row * HPW + cblk + 8 * fq) = pack8(v0, v1);
                }
            }
        }
    }
};
struct EpiResidP {
    static constexpr bool PERM = false;
    float* z; const float* h; const float* modbase; int layer; bool lat;
    DI void operator()(const f32x4 (&acc)[2][2][4][2], const Unit& u, int wr, int wc, int fr, int fq) const {
        const int m0 = u.pm * BM; const int r0 = lat ? ((m0 >> 11) * NTOK + CTXL + (m0 & 2047)) : m0;
        const int row0 = r0 + wr * 64 + fr, col0 = u.pn * BM + wc * 32 + 4 * fq;
        const float* m2 = modbase + ((size_t)(layer * 9 + modrow_of(r0)) * 6 + 2) * 1024 + col0;
        f32x4 mm[2][2];
#pragma unroll
        for (int bj = 0; bj < 2; ++bj)
#pragma unroll
            for (int n = 0; n < 2; ++n) mm[bj][n] = *(const f32x4*)(m2 + bj * HALF + n * 16);
        f32x4 hc[2][2], hn[2][2];
#pragma unroll
        for (int bj = 0; bj < 2; ++bj)
#pragma unroll
            for (int n = 0; n < 2; ++n) hc[bj][n] = *(const f32x4*)(h + (size_t)row0 * D + col0 + bj * HALF + n * 16);
#pragma unroll
        for (int q = 0; q < 8; ++q) {
            const int ai = q >> 2, m = q & 3;
            const int row = row0 + ai * HALF + m * 16;
            const int qn = q < 7 ? q + 1 : 7;
            const int rown = row0 + (qn >> 2) * HALF + (qn & 3) * 16;
#pragma unroll
            for (int bj = 0; bj < 2; ++bj)
#pragma unroll
                for (int n = 0; n < 2; ++n) hn[bj][n] = *(const f32x4*)(h + (size_t)rown * D + col0 + bj * HALF + n * 16);
#pragma unroll
            for (int bj = 0; bj < 2; ++bj)
#pragma unroll
                for (int n = 0; n < 2; ++n)
                    if ((u.rows >> ai) & 1) *(f32x4*)(z + (size_t)row * D + col0 + bj * HALF + n * 16) = ALPHA * hc[bj][n] + mm[bj][n] * acc[ai][bj][m][n];
#pragma unroll
            for (int bj = 0; bj < 2; ++bj)
#pragma unroll
                for (int n = 0; n < 2; ++n) hc[bj][n] = hn[bj][n];
        }
    }
};

struct OrderRkvLora {
    Order o; int nM, extra;
    DI void init(int G, int c) { o.init(T, D, 3, G, c); nM = T / BM; extra = 3 * nM; }
    DI bool decode(long L, Unit& u) const {
        if (L < o.total) {
            u.g = (int)(L / o.per); int wgid = (int)(L - (long)u.g * o.per);
            { const int q = o.per / NXCD, r = o.per % NXCD, xcd = wgid % NXCD, off = wgid / NXCD; wgid = (xcd < r ? xcd * (q + 1) : r * (q + 1) + (xcd - r) * q) + off; }
            const int nig = WGM * o.nN, gid = wgid / nig, fm = gid * WGM, gsz = (o.nM - fm) < WGM ? (o.nM - fm) : WGM;
            u.pm = fm + ((wgid % nig) % gsz); u.pn = (wgid % nig) / gsz; return true;
        }
        const int Lx = (int)(L - o.total); if (Lx >= extra) return false;
        const int gg = Lx / nM; u.g = 3 + gg; u.pm = Lx - gg * nM; u.pn = 0; return true;
    }
    DI bool next(int i, Unit& u) const {
        const int U = o.total + extra, G = o.G, c = o.c, fr = U / G, rem = U - fr * G;
        const bool split = false;
        long L; int half = 3;
        if (!split || i < fr) { L = (long)i * G + c; if (L >= U) return false; }
        else { if (i > fr || c >= 2 * rem) return false; L = (long)fr * G + (c >> 1); half = 1 + (c & 1); }
        u.rows = half; return decode(L, u);
    }
};
struct AddrRkvLora {
    const unsigned char* ws;
    DI const char* a(const Unit& u) const {
        const int mi = u.g < 3 ? u.g + (u.g > 0 ? 1 : 0) : (u.g == 3 ? 1 : u.g);
        return (const char*)((const u16*)(ws + WS_XMIX) + ((size_t)mi * T + (size_t)u.pm * BM) * D);
    }
    DI const char* b(const Unit& u) const {
        const size_t off = u.g < 3 ? WB_RKV + ((size_t)u.g * D + (size_t)u.pn * BM) * D * 2 : (u.g == 3 ? WB_DEC1 : (u.g == 4 ? WB_ICL1 : WB_G1));
        return (const char*)(ws + off);
    }
};
DI f32x4 act4(f32x4 v, int act) {
    if (act == 1) {
#pragma unroll
        for (int e = 0; e < 4; ++e) v[e] = 1.f - 2.f * __builtin_amdgcn_rcpf(1.f + __expf(2.f * v[e]));
    } else if (act == 2) {
#pragma unroll
        for (int e = 0; e < 4; ++e) v[e] = sigmoidf_(v[e]);
    }
    return v;
}
struct EpiRkvLora {
    static constexpr bool PERM = true;
    unsigned char* ws;
    DI void operator()(const f32x4 (&acc)[2][2][4][2], const Unit& u, int wr, int wc, int fr, int fq) const {
        const int row0 = u.pm * BM + wr * 64 + fr;
        if (u.g < 3) {
            u16* base = (u16*)(ws + WS_R + (size_t)u.g * (WS_K - WS_R));
            const int col0 = u.pn * BM + wc * 32 + 8 * fq;
#pragma unroll
            for (int ai = 0; ai < 2; ++ai)
#pragma unroll
                for (int m = 0; m < 4; ++m) { u16* rowp = base + (size_t)(row0 + ai * HALF + m * 16) * D + col0;
#pragma unroll
                    for (int bj = 0; bj < 2; ++bj) *(u32x4*)(rowp + bj * HALF) = pack8(acc[ai][bj][m][0], acc[ai][bj][m][1]); }
        } else {
            const int ld = u.g == 5 ? 192 : 128, nvalid = u.g == 5 ? 160 : 128;
            const size_t off = u.g == 3 ? WS_LW : (u.g == 4 ? WS_LA : WS_SG);
            const int act = u.g == 3 ? 1 : (u.g == 5 ? 2 : 0);
            u16* base = (u16*)(ws + off);
#pragma unroll
            for (int bj = 0; bj < 2; ++bj) {
                const int col = bj * HALF + wc * 32 + 8 * fq;
                if (col < ld) {
                    const bool zero = col >= nvalid;
#pragma unroll
                    for (int ai = 0; ai < 2; ++ai)
#pragma unroll
                        for (int m = 0; m < 4; ++m) {
                            f32x4 v0 = act4(acc[ai][bj][m][0], act), v1 = act4(acc[ai][bj][m][1], act);
                            if (zero) { v0 = (f32x4){0.f, 0.f, 0.f, 0.f}; v1 = v0; }
                            *(u32x4*)(base + (size_t)(row0 + ai * HALF + m * 16) * ld + col) = pack8(v0, v1);
                        }
                }
            }
        }
    }
};

struct ExpSched {
    const LAS int* pt; int NT, nsh, NPN, G, c;
    DI bool next(int i, Unit& u) const {
        const int U = (NT + nsh) * NPN, fr = U / G, rem = U - fr * G;
        const bool split = rem > 0 && 2 * rem <= G;
        int L, half = 3;
        if (!split || i < fr) { const long L_ = (long)i * G + c; if (L_ >= U) return false; L = (int)L_; }
        else { if (i > fr || c >= 2 * rem) return false; L = fr * G + (c >> 1); half = 1 + (c & 1); }
        const int rt = L / NPN; u.pm = rt; u.pn = L - rt * NPN;
        int e = 256, rows = 3;
        if (rt < NT) {
            int lo = 0, hi = 255; while (lo < hi) { const int mid = (lo + hi + 1) >> 1; if (pt[mid] <= rt) lo = mid; else hi = mid - 1; } e = lo;
            const int valid = (pt - 256)[e] - 256 * (rt - pt[e]);
            rows = valid <= 128 ? 1 : 3;
        }
        u.g = e; u.rows = rows & half; return true;
    }
};
struct AddrExp1 {
    const u16* ubuf; const int* arows; const u16* wt; int NT; bool lat;
    DI const char* a0() const { return (const char*)ubuf; }
    DI int arow(const Unit& u, int r) const {
        const int t = (u.pm - NT) * BM + r;
        const int idr = arows[(size_t)(u.pm < NT ? u.pm : 0) * BM + r];
        const int ids = lat ? ((t >> 11) * NTOK + CTXL + (t & 2047)) : t;
        return (u.pm < NT) ? idr : ids;
    }
    DI const char* b(const Unit& u) const { return (const char*)(wt + ((size_t)u.g * 512 + (size_t)u.pn * BM) * 1024); }
};
struct EpiExpH {
    static constexpr bool PERM = true;
    u16* hg; int NT;
    DI void operator()(const f32x4 (&acc)[2][2][4][2], const Unit& u, int wr, int wc, int fr, int fq) const {
        const size_t hrow0 = (u.pm < NT) ? (size_t)u.pm * BM : (size_t)NPMAX + (size_t)(u.pm - NT) * BM;
        const int col0 = u.pn * HALF + wc * 32 + 8 * fq;
#pragma unroll
        for (int ai = 0; ai < 2; ++ai) {
            if (!((u.rows >> ai) & 1)) continue;
#pragma unroll
            for (int m = 0; m < 4; ++m) {
                f32x4 h0, h1;
#pragma unroll
                for (int j = 0; j < 4; ++j) { h0[j] = siluf_(acc[ai][0][m][0][j]) * acc[ai][1][m][0][j]; h1[j] = siluf_(acc[ai][0][m][1][j]) * acc[ai][1][m][1][j]; }
                *(u32x4*)(hg + (hrow0 + (size_t)(ai * HALF + wr * 64 + m * 16 + fr)) * 256 + col0) = pack8(h0, h1);
            }
        }
    }
};
struct AddrExp2 {
    const u16* hg; const u16* wt; int NT;
    DI const char* a(const Unit& u) const { const size_t hrow0 = (u.pm < NT) ? (size_t)u.pm * BM : (size_t)NPMAX + (size_t)(u.pm - NT) * BM; return (const char*)(hg + hrow0 * 256); }
    DI const char* b(const Unit& u) const { return (const char*)(wt + ((size_t)u.g * 1024 + (size_t)u.pn * BM) * 256); }
};
struct EpiExpOut {
    static constexpr bool PERM = true;
    u16* slotb; long shoff; const int* rtk; const float* rw; int NT;
    LAS u32x2* tab;
    struct Pre { int r; float w; };
    DI Pre prefetch(const Unit& u) const {
        const int tid = threadIdx.x & 255; const bool routed = u.pm < NT;
        const size_t sr = (size_t)(routed ? u.pm : 0) * BM + tid;
        const int ortk = rtk[sr]; const float ow = rw[sr];
        Pre q; q.r = routed ? ortk : (u.pm - NT) * BM + tid; q.w = routed ? ow : 1.f; return q;
    }
    DI void commit(const Pre& q, int buf) const { if (threadIdx.x < 256) tab[buf * 256 + threadIdx.x] = (u32x2){(unsigned)q.r, __float_as_uint(q.w)}; }
    DI void operator()(const f32x4 (&acc)[2][2][4][2], const Unit& u, int wr, int wc, int fr, int fq, int buf) const {
        const bool routed = u.pm < NT;
        const int col0 = u.pn * BM + wc * 32 + 8 * fq;
        const int lr0 = wr * 64 + fr;
        u16* base = slotb + (routed ? 0L : shoff) + col0;
#pragma unroll
        for (int ai = 0; ai < 2; ++ai) {
            if (!((u.rows >> ai) & 1)) continue;
#pragma unroll
            for (int m = 0; m < 4; ++m) {
                const u32x2 e = tab[buf * 256 + lr0 + ai * HALF + m * 16];
                const int orow = (int)e[0]; const float w = __uint_as_float(e[1]);
                if (orow >= 0) {
#pragma unroll
                    for (int bj = 0; bj < 2; ++bj) *(u32x4*)(base + (size_t)orow * D + bj * HALF) = pack8(acc[ai][bj][m][0] * w, acc[ai][bj][m][1] * w);
                }
            }
        }
    }
};
}

DI void phase_ada(const Params& p, ldsp lds) {
    LAS float* cact = (LAS float*)(lds + LDS_BASE);
    LAS float* red = cact + 9 * 1024;
    const int tid = threadIdx.x, lane = tid & 63, wave = tid >> 6;
    float* mods = (float*)(p.ws + WS_MODS);
    if (blockIdx.x < 192) {
        for (int i = tid; i < 9 * 1024; i += NTHR) { const float x = (i < 8192) ? p.in[1][i] : p.in[3][i - 8192]; cact[i] = siluf_(x); }
    }
    __syncthreads();
    for (int u = blockIdx.x; u < 192; u += gridDim.x) {
        const int layer = u / 96, slice = u - layer * 96;
        const float* W = p.in[4] + (size_t)layer * 1024 * 6144 + slice * 64;
        const int c4 = tid & 15, kg = tid >> 4;
        f32x4 acc[9];
#pragma unroll
        for (int r = 0; r < 9; ++r) acc[r] = (f32x4){0.f, 0.f, 0.f, 0.f};
#pragma unroll
        for (int hb = 0; hb < 2; ++hb) {
            f32x4 wv[16];
#pragma unroll
            for (int i = 0; i < 16; ++i) wv[i] = *(const f32x4*)(W + (size_t)(kg + 32 * (hb * 16 + i)) * 6144 + c4 * 4);
#pragma unroll
            for (int i = 0; i < 16; ++i) {
                const int k = kg + 32 * (hb * 16 + i);
#pragma unroll
                for (int r = 0; r < 9; ++r) acc[r] += cact[r * 1024 + k] * wv[i];
            }
        }
#pragma unroll
        for (int r = 0; r < 9; ++r)
#pragma unroll
            for (int e = 0; e < 4; ++e) { float v = acc[r][e]; v += __shfl_xor(v, 16); v += __shfl_xor(v, 32); acc[r][e] = v; }
        if (lane < 16) {
#pragma unroll
            for (int r = 0; r < 9; ++r) *(LAS f32x4*)(red + (wave * 9 + r) * 64 + c4 * 4) = acc[r];
        }
        __syncthreads();
        for (int i = tid; i < 576; i += NTHR) {
            const int r = i >> 6, col = i & 63;
            float s = 0.f;
#pragma unroll
            for (int w = 0; w < 8; ++w) s += red[(w * 9 + r) * 64 + col];
            s += p.in[5][layer * 6144 + slice * 64 + col];
            mods[(size_t)(layer * 9 + r) * 6144 + slice * 64 + col] = s;
        }
        __syncthreads();
    }
}


DI void cvt_tr(ldsp lds, const float* src, int lds_, int K, int N, int Kp, int Np, u16* dst, int dn0, int boff = 0) {
    LAS float* tile = (LAS float*)(lds + LDS_BASE);
    const int tid = threadIdx.x;
    const int tk = (Kp + 63) >> 6, tn = (Np + 63) >> 6;
    const int G_ = (int)gridDim.x;
    for (int t = ((int)blockIdx.x + G_ - boff % G_) % G_; t < tk * tn; t += G_) {
        const int k0 = (t / tn) * 64, n0 = (t % tn) * 64;
        __syncthreads();
#pragma unroll
        for (int j = 0; j < 8; ++j) {
            const int e = tid + 512 * j, kk = e >> 6, nn = e & 63;
            float v = 0.f;
            if (k0 + kk < K && n0 + nn < N) v = src[(size_t)(k0 + kk) * lds_ + n0 + nn];
            tile[kk * 65 + nn] = v;
        }
        __syncthreads();
#pragma unroll
        for (int j = 0; j < 8; ++j) {
            const int e = tid + 512 * j, nn = e >> 6, kk = e & 63;
            if (k0 + kk < Kp && n0 + nn < Np) dst[(size_t)(dn0 + n0 + nn) * Kp + k0 + kk] = f2bf(tile[kk * 65 + nn]);
        }
    }
}
DI void cvt_rows(const float* src, u16* dst, size_t n4, size_t gtid, size_t gsz) {
    for (size_t i = gtid; i < n4; i += gsz) {
        const f32x4 v = *(const f32x4*)(src + i * 4);
        u32x2 o; o[0] = pack2(v[0], v[1]); o[1] = pack2(v[2], v[3]);
        *(u32x2*)(dst + i * 4) = o;
    }
}
struct DStrip { const float* src; u16* dst; int N, k0, n0; };
DI DStrip dense_strip(const Params& p, int s) {
    s = s < 464 ? s : 463;
    DStrip d; int t;
    if (s < 144) { d.src = p.in[8]; d.dst = (u16*)(p.ws + WB_WIN); d.N = 2304; t = s; d.k0 = (t / 9) * 64; d.n0 = (t % 9) * 256; return d; }
    s -= 144; const int m = s >> 6; t = s & 63; d.N = 1024; d.k0 = (t >> 2) * 64; d.n0 = (t & 3) * 256;
    d.src = m == 0 ? p.in[9] : (m < 4 ? p.in[14] + (size_t)(m - 1) * 1024 * 1024 : p.in[15]);
    const size_t off = m == 0 ? WB_WOUT : (m < 4 ? WB_RKV + (size_t)(m - 1) * 1024 * 1024 * 2 : WB_RKO);
    d.dst = (u16*)(p.ws + off); return d;
}
DI void dense_ld(const Params& p, int s, f32x4 (&v)[8]) {
    const DStrip d = dense_strip(p, s);
    const int tid = threadIdx.x, w = tid >> 6, kb = (tid & 63) >> 3, ng = tid & 7;
    const float* q = d.src + (size_t)(d.k0 + 8 * kb) * d.N + d.n0 + 32 * w + 4 * ng;
#pragma unroll
    for (int j = 0; j < 8; ++j) v[j] = *(const f32x4*)(q + (size_t)j * d.N);
}
DI void dense_st(const Params& p, int s, const f32x4 (&v)[8]) {
    if (s >= 464) return;
    const DStrip d = dense_strip(p, s);
    const int tid = threadIdx.x, w = tid >> 6, kb = (tid & 63) >> 3, ng = tid & 7;
#pragma unroll
    for (int i = 0; i < 4; ++i)
        *(u32x4*)(d.dst + (size_t)(d.n0 + 32 * w + 4 * ng + i) * 1024 + d.k0 + 8 * kb) = (u32x4){pack2(v[0][i], v[1][i]), pack2(v[2][i], v[3][i]), pack2(v[4][i], v[5][i]), pack2(v[6][i], v[7][i])};
}
DI void phase_cvt(const Params& p, ldsp lds) {
    {
        const int G = (int)gridDim.x; int s0 = (int)blockIdx.x, s1 = s0 + G;
        f32x4 v0[8], v1[8];
        dense_ld(p, s0, v0); dense_ld(p, s1, v1);
        while (s0 < 464) {
            dense_st(p, s0, v0); s0 += 2 * G; dense_ld(p, s0, v0);
            dense_st(p, s1, v1); s1 += 2 * G; dense_ld(p, s1, v1);
        }
    }
    int bo = 0;
    for (int d = 0; d < 2; ++d) {
        cvt_tr(lds, p.in[17] + (size_t)d * 1024 * 64, 64, 1024, 64, 1024, d ? 192 : 64, (u16*)(p.ws + WB_DEC1), d * 64, bo); bo += d ? 48 : 16;
        cvt_tr(lds, p.in[20] + (size_t)d * 1024 * 64, 64, 1024, 64, 1024, d ? 192 : 64, (u16*)(p.ws + WB_ICL1), d * 64, bo); bo += d ? 48 : 16;
        cvt_tr(lds, p.in[18] + (size_t)d * 64 * 1024, 1024, 64, 1024, 64, 1024, (u16*)(p.ws + WB_DEC2) + (size_t)d * 1024 * 64, 0, bo); bo += 16;
        cvt_tr(lds, p.in[21] + (size_t)d * 64 * 1024, 1024, 64, 1024, 64, 1024, (u16*)(p.ws + WB_ICL2) + (size_t)d * 1024 * 64, 0, bo); bo += 16;
    }
    cvt_tr(lds, p.in[22], 160, 1024, 160, 1024, 256, (u16*)(p.ws + WB_G1), 0, bo); bo += 64;
    cvt_tr(lds, p.in[23], 1024, 160, 1024, 192, 1024, (u16*)(p.ws + WB_G2), 0, bo);
}


DI void phase_cvt_experts(const Params& p, ldsp lds) {
    LAS float* tl = (LAS float*)(lds + LDS_BASE);
    const int tid = threadIdx.x;
    const int nstrip = 2 * 257 * 48;
    f32x4 ra[8], rb[8];
#define CE_DECODE(st, src, ld, k0, n0, dst, dld, isin) \
        const int le_ = (st) / 48, r_ = (st) - le_ * 48; const int layer_ = le_ / 257, e_ = le_ - layer_ * 257; \
        const bool isin = r_ < 32; \
        const int k0 = isin ? (r_ >> 1) * 64 : ((r_ - 32) >> 2) * 64, n0 = isin ? (r_ & 1) * 256 : ((r_ - 32) & 3) * 256; \
        const float* src = isin ? ((e_ < 256) ? p.in[30] + ((size_t)layer_ * 256 + e_) * 1024 * 512 : p.in[32] + (size_t)layer_ * 1024 * 512) \
                                : ((e_ < 256) ? p.in[31] + ((size_t)layer_ * 256 + e_) * 256 * 1024 : p.in[33] + (size_t)layer_ * 256 * 1024); \
        const int ld = isin ? 512 : 1024; \
        u16* dst = isin ? (u16*)(p.ws + WT_IN) + ((size_t)layer_ * 257 + e_) * 512 * 1024 : (u16*)(p.ws + WT_OUT) + ((size_t)layer_ * 257 + e_) * 1024 * 256; \
        const int dld = isin ? 1024 : 256;
#define CE_LOAD(R, st) do { const int sc_ = (st) < nstrip ? (st) : nstrip - 1; CE_DECODE(sc_, src_, ld_, k0_, n0_, dst_, dld_, isin_) (void)dst_; (void)dld_; (void)isin_; \
        _Pragma("unroll") for (int q = 0; q < 8; ++q) R[q] = *(const f32x4*)(src_ + (size_t)(k0_ + (tid >> 6) + 8 * q) * ld_ + n0_ + (tid & 63) * 4); } while (0)
#define CE_DRAIN(R, st) do { \
        __syncthreads(); \
        _Pragma("unroll") for (int q = 0; q < 8; ++q) *(LAS f32x4*)(tl + ((tid >> 6) + 8 * q) * 260 + (tid & 63) * 4) = R[q]; \
        __syncthreads(); \
        if ((st) < nstrip) { CE_DECODE(st, src_, ld_, k0_, n0_, dst_, dld_, isin_) (void)src_; (void)ld_; \
            _Pragma("unroll") for (int q = 0; q < 4; ++q) { const int id_ = tid + 512 * q, n_ = id_ & 255, c_ = id_ >> 8; \
                float v_[8]; _Pragma("unroll") for (int j = 0; j < 8; ++j) v_[j] = tl[(c_ * 8 + j) * 260 + n_]; \
                const int nn_ = n0_ + n_; \
                const int rho_ = isin_ ? (((nn_ & 255) >> 7) * 256 + (nn_ >> 8) * 128 + (nn_ & 127)) : nn_; \
                *(u32x4*)(dst_ + (size_t)rho_ * dld_ + k0_ + c_ * 8) = (u32x4){pack2(v_[0], v_[1]), pack2(v_[2], v_[3]), pack2(v_[4], v_[5]), pack2(v_[6], v_[7])}; } } } while (0)
    int st = blockIdx.x;
    CE_LOAD(ra, st); CE_LOAD(rb, st + (int)gridDim.x);
    for (; st < nstrip; st += 2 * (int)gridDim.x) {
        CE_DRAIN(ra, st); CE_LOAD(ra, st + 2 * (int)gridDim.x);
        CE_DRAIN(rb, st + (int)gridDim.x); CE_LOAD(rb, st + 3 * (int)gridDim.x);
    }
#undef CE_DECODE
#undef CE_LOAD
#undef CE_DRAIN
}

DI void phase_mod0(const Params& p) {
    const int lane = threadIdx.x & 63, wave = threadIdx.x >> 6;
    float* hbuf = (float*)(p.ws + WS_H); u16* ubuf = (u16*)(p.ws + WS_U);
    for (int row = blockIdx.x * 8 + wave; row < T; row += gridDim.x * 8) {
        const int b = row / NTOK, n = row - b * NTOK;
        const float* src = (n < CTXL) ? p.in[2] + ((size_t)b * CTXL + n) * D : p.in[0] + ((size_t)b * SEQ + (n - CTXL)) * D;
        const int mr = (n < CTXL) ? 8 : b;
        const float* m0 = mods_ptr(p, 0, mr, 0); const float* m1 = mods_ptr(p, 0, mr, 1);
#pragma unroll
        for (int j = 0; j < 4; ++j) {
            const int col = lane * 4 + 256 * j;
            const f32x4 h = __builtin_nontemporal_load((const f32x4*)(src + col));
            const f32x4 a = *(const f32x4*)(m0 + col), s = *(const f32x4*)(m1 + col);
            const f32x4 u = h * (1.f + s) + a;
            *(f32x4*)(hbuf + (size_t)row * D + col) = h;
            u32x2 o; o[0] = pack2(u[0], u[1]); o[1] = pack2(u[2], u[3]);
            *(u32x2*)(ubuf + (size_t)row * D + col) = o;
        }
    }
}

DI void ld_bf8(const u16* p, f32x4& a, f32x4& b) {
    const u32x4 v = __builtin_nontemporal_load((const u32x4*)p);
    a = (f32x4){__uint_as_float(v[0] << 16), __uint_as_float(v[0] & 0xffff0000u), __uint_as_float(v[1] << 16), __uint_as_float(v[1] & 0xffff0000u)};
    b = (f32x4){__uint_as_float(v[2] << 16), __uint_as_float(v[2] & 0xffff0000u), __uint_as_float(v[3] << 16), __uint_as_float(v[3] & 0xffff0000u)};
}
template <int MODE>
DI void phase_ln(const Params& p, int layer, bool lat_only) {
    const int lane = threadIdx.x & 63, wave = threadIdx.x >> 6;
    float* hbuf = (float*)(p.ws + WS_H); u16* ubuf = (u16*)(p.ws + WS_U);
    float* zbuf = (float*)(p.ws + WS_Z);
    const int nrows = lat_only ? TL : T;
    const int which = (MODE == 0) ? 0 : 1;
    const float* g = p.in[6] + (size_t)(layer * 2 + which) * D; const float* bb = p.in[7] + (size_t)(layer * 2 + which) * D;
    for (int m = blockIdx.x * 8 + wave; m < nrows; m += gridDim.x * 8) {
        const int row = lat_only ? ((m >> 11) * NTOK + CTXL + (m & 2047)) : m;
        const int mr = modrow_of(row);
        f32x4 x[2][2];
        float s = 0.f;
#pragma unroll
        for (int j = 0; j < 2; ++j) {
            const int col = lane * 8 + 512 * j;
            if (MODE == 0) { x[j][0] = __builtin_nontemporal_load((const f32x4*)(zbuf + (size_t)row * D + col)); x[j][1] = __builtin_nontemporal_load((const f32x4*)(zbuf + (size_t)row * D + col + 4)); }
            else {
                const f32x4 h0 = *(const f32x4*)(hbuf + (size_t)row * D + col), h1 = *(const f32x4*)(hbuf + (size_t)row * D + col + 4);
                f32x4 a0, a1; ld_bf8((const u16*)(p.ws + WS_SH) + (size_t)m * D + col, a0, a1);
#pragma unroll
                for (int k8 = 0; k8 < 8; ++k8) { f32x4 t0, t1; ld_bf8((const u16*)(p.ws + WS_SLOT) + ((size_t)m * 8 + k8) * D + col, t0, t1); a0 += t0; a1 += t1; }
                const float* m5 = mods_ptr(p, layer, mr, 5) + col;
                x[j][0] = ALPHA * h0 + *(const f32x4*)m5 * a0; x[j][1] = ALPHA * h1 + *(const f32x4*)(m5 + 4) * a1;
            }
#pragma unroll
            for (int q = 0; q < 2; ++q) s += x[j][q][0] + x[j][q][1] + x[j][q][2] + x[j][q][3];
        }
        const float mu = wsum64(s) * (1.f / D);
        float v = 0.f;
#pragma unroll
        for (int j = 0; j < 2; ++j)
#pragma unroll
            for (int q = 0; q < 2; ++q) { const f32x4 d = x[j][q] - mu; v += d[0] * d[0] + d[1] * d[1] + d[2] * d[2] + d[3] * d[3]; }
        const float rs = rsqrtf(wsum64(v) * (1.f / D) + LN_EPS);
#pragma unroll
        for (int j = 0; j < 2; ++j) {
            const int col = lane * 8 + 512 * j;
            f32x4 hn[2];
#pragma unroll
            for (int q = 0; q < 2; ++q) hn[q] = (x[j][q] - mu) * rs * *(const f32x4*)(g + col + 4 * q) + *(const f32x4*)(bb + col + 4 * q);
            if (MODE == 0) {
                *(f32x4*)(hbuf + (size_t)row * D + col) = hn[0]; *(f32x4*)(hbuf + (size_t)row * D + col + 4) = hn[1];
                const float* m4 = mods_ptr(p, layer, mr, 4) + col; const float* m3 = mods_ptr(p, layer, mr, 3) + col;
                const f32x4 u0 = hn[0] * (1.f + *(const f32x4*)m4) + *(const f32x4*)m3, u1 = hn[1] * (1.f + *(const f32x4*)(m4 + 4)) + *(const f32x4*)(m3 + 4);
                *(u32x4*)(ubuf + (size_t)row * D + col) = pack8(u0, u1);
            } else if (MODE == 1) {
                *(f32x4*)(hbuf + (size_t)row * D + col) = hn[0]; *(f32x4*)(hbuf + (size_t)row * D + col + 4) = hn[1];
                const float* m1 = mods_ptr(p, layer + 1, mr, 1) + col; const float* m0 = mods_ptr(p, layer + 1, mr, 0) + col;
                *(f32x4*)(zbuf + (size_t)row * D + col) = hn[0] * (1.f + *(const f32x4*)m1) + *(const f32x4*)m0;
                *(f32x4*)(zbuf + (size_t)row * D + col + 4) = hn[1] * (1.f + *(const f32x4*)(m1 + 4)) + *(const f32x4*)(m0 + 4);
            } else {
                *(f32x4*)(p.out + (size_t)m * D + col) = hn[0]; *(f32x4*)(p.out + (size_t)m * D + col + 4) = hn[1];
            }
        }
    }
}


constexpr int BG_NV = 8;
constexpr int BG_NSTRIP = 2 * 257 * 48;
struct BgCvt { int st, pst, lim, stride; f32x4 pend[BG_NV]; };
struct BgStrip { const float* src; u16* dst; int ld, dld, k0, n0; bool isin; };
DI BgStrip bg_decode(const Params& p, int st, int lim) {
    st = st < 0 ? 0 : (st < lim ? st : lim - 1);
    BgStrip d;
    const int le = st / 48, r = st - le * 48; const int layer = le / 257, e = le - layer * 257;
    d.isin = r < 32;
    d.k0 = d.isin ? (r >> 1) * 64 : ((r - 32) >> 2) * 64; d.n0 = d.isin ? (r & 1) * 256 : ((r - 32) & 3) * 256;
    d.src = d.isin ? ((e < 256) ? p.in[30] + ((size_t)layer * 256 + e) * 1024 * 512 : p.in[32] + (size_t)layer * 1024 * 512)
                   : ((e < 256) ? p.in[31] + ((size_t)layer * 256 + e) * 256 * 1024 : p.in[33] + (size_t)layer * 256 * 1024);
    d.ld = d.isin ? 512 : 1024;
    d.dst = d.isin ? (u16*)(p.ws + WT_IN) + ((size_t)layer * 257 + e) * 512 * 1024 : (u16*)(p.ws + WT_OUT) + ((size_t)layer * 257 + e) * 1024 * 256;
    d.dld = d.isin ? 1024 : 256;
    return d;
}
DI void bg_load(const Params& p, BgCvt& c) {
    if (c.st < 0 || c.st >= c.lim) { c.pst = c.st; c.st += c.stride; return; }
    const BgStrip d = bg_decode(p, c.st, c.lim);
    const int tid = threadIdx.x, w = tid >> 6, kb = (tid & 63) >> 3, ng = tid & 7;
    const float* s = d.src + (size_t)(d.k0 + 8 * kb) * d.ld + d.n0 + 32 * w + 4 * ng;
#pragma unroll
    for (int j = 0; j < BG_NV; ++j) c.pend[j] = __builtin_nontemporal_load((const f32x4*)(s + (size_t)j * d.ld));
    c.pst = c.st; c.st += c.stride;
}
DI void bg_store(const Params& p, BgCvt& c) {
    const BgStrip d = bg_decode(p, c.pst, c.lim);
    const int tid = threadIdx.x, w = tid >> 6, kb = (tid & 63) >> 3, ng = tid & 7;
    const int nkt = d.dld >> 6, kt = d.k0 >> 6;
    if (c.pst < 0 || c.pst >= c.lim) return;
#pragma unroll
    for (int i = 0; i < 4; ++i) {
        const int nn = d.n0 + 32 * w + 4 * ng + i;
        const int rho = d.isin ? (((nn & 255) >> 7) * 256 + (nn >> 8) * 128 + (nn & 127)) : nn;
        __builtin_nontemporal_store((u32x4){pack2(c.pend[0][i], c.pend[1][i]), pack2(c.pend[2][i], c.pend[3][i]), pack2(c.pend[4][i], c.pend[5][i]), pack2(c.pend[6][i], c.pend[7][i])},
                                    (u32x4*)(d.dst + ((size_t)((rho >> 8) * nkt + kt) * 256 + (rho & 255)) * 64 + 8 * kb));
    }
}
DI BgCvt bg_make(const Params& p, int start, int lim, int stride) { BgCvt c; c.st = start; c.pst = start; c.lim = lim; c.stride = stride; bg_load(p, c); return c; }
constexpr int BG_Q = 14;
DI int bg_idle(int ntiles) { const int i_ = (int)gridDim.x - ntiles; return i_ > 0 ? i_ : 0; }
DI int bg_s2() { return BG_NSTRIP - BG_Q * bg_idle(TL / 128); }
DI int bg_s1() { return bg_s2() - BG_Q * bg_idle(T / 128); }
DI void bg_idle_run(const Params& p, int ntiles, int lo, int hi) {
    const int nm = bg_idle(ntiles), mem = (int)blockIdx.x - ntiles;
    if (mem < 0 || lo >= hi) return;
    BgCvt c0 = bg_make(p, lo + mem, hi, 2 * nm), c1 = bg_make(p, lo + mem + nm, hi, 2 * nm);
    while (c0.pst + c0.stride < c0.lim || c1.pst + c1.stride < c1.lim) {
        bg_store(p, c0); bg_load(p, c0); bg_store(p, c1); bg_load(p, c1);
    }
    bg_store(p, c0); bg_store(p, c1);
}
DI void bg_step(const Params& p, BgCvt& c) { bg_store(p, c); bg_load(p, c); }
DI void bg_finish(const Params& p, BgCvt& c) { while (c.pst + c.stride < c.lim) bg_step(p, c); bg_store(p, c); }

constexpr int K_STR = 144;
template <bool ISB>
DI void attn_unit(const Params& p, ldsp lds, BgCvt& bgc, const u16* hp, int b, int ntiles, int nlin, int win_n0, bool use_mask, int qn,
                  const int* qcol, const int* kcol, int vcol, f32x4 (&O)[ISB ? 2 : 1][ISB ? 8 : 4], float* lsum, float* mrun) {
    constexpr int NM = ISB ? 2 : 1, DV = ISB ? 128 : 64, NDT = DV / 16, VSTR = (DV + 8) * 2, NVC = ISB ? 2 : 1;
    const int tid = threadIdx.x, lane = tid & 63, g = lane >> 4;
    ldsp Ks = lds + LDS_BASE;
    ldsp Vs = Ks + 2 * 64 * K_STR;
    const float sc = 0.125f * L2E;
    s16x8 qf[NM][2];
#pragma unroll
    for (int m = 0; m < NM; ++m)
#pragma unroll
        for (int ks = 0; ks < 2; ++ks)
            qf[m][ks] = *(const s16x8*)(hp + (size_t)(b * NTOK + qn) * HPW + qcol[m] + ks * 32 + g * 8);
#pragma unroll
    for (int m = 0; m < NM; ++m) {
        lsum[m] = 0.f; mrun[m] = -1e30f;
#pragma unroll
        for (int dt = 0; dt < NDT; ++dt) O[m][dt] = (f32x4){0.f, 0.f, 0.f, 0.f};
    }
    u32x4 rk[NM], rv[NVC];
#define N0_OF(ti) ((ti) < nlin ? (ti) * 64 : win_n0 + ((ti) - nlin) * 64)
    {
        const int n0 = N0_OF(0);
#pragma unroll
        for (int m = 0; m < NM; ++m) rk[m] = *(const u32x4*)(hp + (size_t)(b * NTOK + n0 + (tid >> 3)) * HPW + kcol[m] + (tid & 7) * 8);
#pragma unroll
        for (int s = 0; s < NVC; ++s) {
            const int c = tid + 512 * s; const int key = ISB ? (c >> 4) : (c >> 3), ch = ISB ? (c & 15) : (c & 7);
            rv[s] = *(const u32x4*)(hp + (size_t)(b * NTOK + n0 + key) * HPW + vcol + ch * 8);
        }
    }
    for (int ti = 0; ti < ntiles; ++ti) {
        const int n0 = N0_OF(ti);
        __syncthreads();
#pragma unroll
        for (int m = 0; m < NM; ++m) *(LAS u32x4*)(Ks + m * 64 * K_STR + (tid >> 3) * K_STR + (tid & 7) * 16) = rk[m];
#pragma unroll
        for (int s = 0; s < NVC; ++s) {
            const int c = tid + 512 * s; const int key = ISB ? (c >> 4) : (c >> 3), ch = ISB ? (c & 15) : (c & 7);
            *(LAS u32x4*)(Vs + key * VSTR + ch * 16) = rv[s];
        }
        __syncthreads();
        {
            const int tn_ = (ti + 1 < ntiles) ? ti + 1 : ntiles - 1;
            const int n1 = N0_OF(tn_);
#pragma unroll
            for (int m = 0; m < NM; ++m) rk[m] = *(const u32x4*)(hp + (size_t)(b * NTOK + n1 + (tid >> 3)) * HPW + kcol[m] + (tid & 7) * 8);
#pragma unroll
            for (int s = 0; s < NVC; ++s) {
                const int c = tid + 512 * s; const int key = ISB ? (c >> 4) : (c >> 3), ch = ISB ? (c & 15) : (c & 7);
                rv[s] = *(const u32x4*)(hp + (size_t)(b * NTOK + n1 + key) * HPW + vcol + ch * 8);
            }
        }
        bg_step(p, bgc);
        const bool masked = use_mask && (ti >= nlin);
        s16x8 pf[NM][2];
#pragma unroll
        for (int m = 0; m < NM; ++m) {
            f32x4 st[4];
#pragma unroll
            for (int kt = 0; kt < 4; ++kt) {
                st[kt] = (f32x4){0.f, 0.f, 0.f, 0.f};
#pragma unroll
                for (int ks = 0; ks < 2; ++ks) {
                    const s16x8 a = *(const LAS s16x8*)(Ks + m * 64 * K_STR + (kt * 16 + (lane & 15)) * K_STR + ks * 64 + g * 16);
                    st[kt] = __builtin_amdgcn_mfma_f32_16x16x32_bf16(a, qf[m][ks], st[kt], 0, 0, 0);
                }
            }
            float mx = -1e30f;
#pragma unroll
            for (int kt = 0; kt < 4; ++kt)
#pragma unroll
                for (int i = 0; i < 4; ++i) {
                    float s2 = st[kt][i] * sc;
                    if (masked) {
                        const int kpos = n0 - CTXL + kt * 16 + g * 4 + i, qpos = qn - CTXL;
                        const int dd = qpos - kpos;
                        if (dd > 128 || dd < -128) s2 = -1e30f;
                    }
                    st[kt][i] = s2; mx = fmaxf(mx, s2);
                }
            mx = fmaxf(mx, __shfl_xor(mx, 16)); mx = fmaxf(mx, __shfl_xor(mx, 32));
            const float mnew = fmaxf(mrun[m], mx);
            const float alpha = __builtin_amdgcn_exp2f(mrun[m] - mnew);
            mrun[m] = mnew;
            float ps = 0.f;
#pragma unroll
            for (int kt = 0; kt < 4; ++kt)
#pragma unroll
                for (int i = 0; i < 4; ++i) { const float pv = __builtin_amdgcn_exp2f(st[kt][i] - mnew); st[kt][i] = pv; ps += pv; }
            lsum[m] = lsum[m] * alpha + ps;
#pragma unroll
            for (int dt = 0; dt < NDT; ++dt) O[m][dt] *= alpha;
#pragma unroll
            for (int k2 = 0; k2 < 2; ++k2) {
                const unsigned w0 = pack2(st[2 * k2][0], st[2 * k2][1]), w1 = pack2(st[2 * k2][2], st[2 * k2][3]);
                const unsigned w2 = pack2(st[2 * k2 + 1][0], st[2 * k2 + 1][1]), w3 = pack2(st[2 * k2 + 1][2], st[2 * k2 + 1][3]);
                const u32x4 w = (u32x4){w0, w1, w2, w3};
                pf[m][k2] = __builtin_bit_cast(s16x8, w);
            }
        }
        const LAS unsigned char* vb = Vs + (4 * g + ((lane >> 2) & 3)) * VSTR + (4 * (lane & 3)) * 2;
#pragma unroll
        for (int dt = 0; dt < NDT; ++dt)
#pragma unroll
            for (int k2 = 0; k2 < 2; ++k2) {
                const s16x4 lo = vtr(vb + (32 * k2) * VSTR + dt * 32);
                const s16x4 hi = vtr(vb + (32 * k2 + 16) * VSTR + dt * 32);
                const s16x8 vf = (s16x8){lo[0], lo[1], lo[2], lo[3], hi[0], hi[1], hi[2], hi[3]};
#pragma unroll
                for (int m = 0; m < NM; ++m) O[m][dt] = __builtin_amdgcn_mfma_f32_16x16x32_bf16(vf, pf[m][k2], O[m][dt], 0, 0, 0);
            }
    }
#pragma unroll
    for (int m = 0; m < NM; ++m) { float l = lsum[m]; l += __shfl_xor(l, 16); l += __shfl_xor(l, 32); lsum[m] = l; }
}

DI void phase_attn(const Params& p, ldsp lds) {
    const int tid = threadIdx.x, lane = tid & 63, wave = tid >> 6, g = lane >> 4;
    const u16* hp = (const u16*)(p.ws + WS_HP);
    u16* ao = (u16*)(p.ws + WS_AO);
    float lam;
    {
        const float* lv = p.in[11];
        float d0 = 0.f, d1 = 0.f;
        for (int i = 0; i < 64; ++i) { d0 += lv[i] * lv[64 + i]; d1 += lv[128 + i] * lv[192 + i]; }
        lam = expf(d0) - expf(d1) + 0.2f;
    }
    const int NU_BL = 512, NU_AL = 1024, NU_BC = 64, NU_AC = 128;
    const int total = NU_BL + NU_AL + NU_BC + NU_AC;
    BgCvt bgc = bg_make(p, (int)blockIdx.x - (int)((blockIdx.x >> 3) & 3) * 9 * (int)gridDim.x, bg_s1(), (int)gridDim.x);
    const int G_ = (int)gridDim.x;
    const int vcu_ = (G_ % 8 == 0) ? (int)((blockIdx.x % 8) * (G_ / 8) + blockIdx.x / 8) : (int)blockIdx.x;
    for (int u = vcu_; u < total; u += G_) {
        if (u < NU_BL || (u >= NU_BL + NU_AL && u < NU_BL + NU_AL + NU_BC)) {
            const bool isctx = u >= NU_BL;
            const int uu = isctx ? u - (NU_BL + NU_AL) : u;
            int b, h, qt;
            if (!isctx) { b = uu >> 6; h = (uu >> 4) & 3; qt = uu & 15; } else { b = uu >> 3; h = (uu >> 1) & 3; qt = uu & 1; }
            const int qn = (isctx ? 0 : CTXL) + qt * 128 + wave * 16 + (lane & 15);
            const int qcol[2] = {768 + h * 128, 768 + h * 128 + 64};
            const int kcol[2] = {1280 + h * 128, 1280 + h * 128 + 64};
            const int vcol = 1792 + h * 128;
            f32x4 O[2][8]; float ls[2], mr[2];
            const int ntiles = isctx ? 4 : 36;
            attn_unit<true>(p, lds, bgc, hp, b, ntiles, ntiles, 0, false, qn, qcol, kcol, vcol, O, ls, mr);
            const float il0 = 1.f / ls[0], il1 = lam / ls[1];
            float ss = 0.f;
#pragma unroll
            for (int dt = 0; dt < 8; ++dt)
#pragma unroll
                for (int i = 0; i < 4; ++i) { const float a = O[0][dt][i] * il0 - O[1][dt][i] * il1; O[0][dt][i] = a; ss += a * a; }
            ss += __shfl_xor(ss, 16); ss += __shfl_xor(ss, 32);
            const float rn = rsqrtf(ss * (1.f / 128.f) + 1e-5f) * 0.8f;
            const float* sg = p.in[12];
            u16* orow = ao + (size_t)(b * NTOK + qn) * D + 512 + h * 128;
#pragma unroll
            for (int dt = 0; dt < 8; ++dt) {
                const int dv = dt * 16 + g * 4;
                u32x2 o;
                o[0] = pack2(O[0][dt][0] * rn * sg[dv], O[0][dt][1] * rn * sg[dv + 1]);
                o[1] = pack2(O[0][dt][2] * rn * sg[dv + 2], O[0][dt][3] * rn * sg[dv + 3]);
                *(u32x2*)(orow + dv) = o;
            }
        } else {
            const bool isctx = u >= NU_BL + NU_AL + NU_BC;
            const int uu = isctx ? u - (NU_BL + NU_AL + NU_BC) : u - NU_BL;
            int b, kvh, pb;
            if (!isctx) { b = uu >> 7; kvh = (uu >> 6) & 1; pb = uu & 63; } else { b = uu >> 4; kvh = (uu >> 3) & 1; pb = uu & 7; }
            const int gh = wave & 3, head = kvh * 4 + gh;
            const int pos = pb * 32 + (wave >> 2) * 16 + (lane & 15);
            const int qn = (isctx ? 0 : CTXL) + pos;
            int ntiles = 4, win_n0 = 0;
            if (!isctx) {
                int lo = pb * 32 - 128; if (lo < 0) lo = 0; lo &= ~63;
                int hi = pb * 32 + 160; if (hi > SEQ) hi = SEQ;
                ntiles = 4 + (hi - lo + 63) / 64; win_n0 = CTXL + lo;
            }
            const int qcol[1] = {head * 64}; const int kcol[1] = {512 + kvh * 64}; const int vcol = 640 + kvh * 64;
            f32x4 O[1][4]; float ls[1], mr[1];
            attn_unit<false>(p, lds, bgc, hp, b, ntiles, 4, win_n0, !isctx, qn, qcol, kcol, vcol, O, ls, mr);
            const float sink = p.in[10][kvh * 4 + gh];
            const float l = ls[0] + __builtin_amdgcn_exp2f(sink * L2E - mr[0]);
            const float il = 1.f / l;
            u16* orow = ao + (size_t)(b * NTOK + qn) * D + head * 64;
#pragma unroll
            for (int dt = 0; dt < 4; ++dt) {
                const int dv = dt * 16 + g * 4;
                u32x2 o; o[0] = pack2(O[0][dt][0] * il, O[0][dt][1] * il); o[1] = pack2(O[0][dt][2] * il, O[0][dt][3] * il);
                *(u32x2*)(orow + dv) = o;
            }
        }
    }
    bg_finish(p, bgc);
}

DI int tok_row(int t, bool lat_only) { return lat_only ? ((t >> 11) * NTOK + CTXL + (t & 2047)) : t; }

DI void phase_topk(const Params& p, int layer, int ntok, ldsp lds) {
    constexpr int TPBMAX = 80, SSTR = 260;
    LAS float* scl = (LAS float*)(lds + LDS_BASE);
    LAS float* biasl = scl + TPBMAX * SSTR;
    LAS float* gscl = biasl + 256;
    LAS float* lval = gscl + TPBMAX * 8;
    LAS float* lsv = lval + TPBMAX * 32;
    LAS int* lidx = (LAS int*)(lsv + TPBMAX * 32);
    const int tid = threadIdx.x, tok = tid >> 2, q = tid & 3;
    const float* sc = (const float*)(p.ws + WS_SC);
    const float* bias = p.in[29] + layer * 256;
    int* eidx = (int*)(p.ws + WS_EIDX); float* gw = (float*)(p.ws + WS_GW); int* epos = (int*)(p.ws + WS_EPOS);
    int* cnt = (int*)(p.ws + CTL_CNT) + layer * 256 * CNT_STR;
    const int G = gridDim.x;
    int TPB = (ntok + G - 1) / G; TPB = TPB > TPBMAX ? TPBMAX : TPB;
    for (int base = blockIdx.x * TPB; base < ntok; base += G * TPB) {
        const int n = (ntok - base) < TPB ? (ntok - base) : TPB;
        __syncthreads();
        if (tid < 64) *(LAS f32x4*)(biasl + tid * 4) = *(const f32x4*)(bias + tid * 4);
        for (int i = tid; i < n * 64; i += NTHR) { const int tk_ = i >> 6, c4 = i & 63; *(LAS f32x4*)(scl + tk_ * SSTR + c4 * 4) = *(const f32x4*)(sc + (size_t)(base + tk_) * 256 + c4 * 4); }
        __syncthreads();
        const bool act = tok < n;
        const int tk = act ? tok : n - 1;
        {
#pragma unroll
            for (int h = 0; h < 2; ++h) {
                const int g = 2 * q + h; float m1 = -3e38f, m2 = -3e38f;
#pragma unroll
                for (int j = 0; j < 8; ++j) {
                    const f32x4 s4 = *(const LAS f32x4*)(scl + tk * SSTR + g * 32 + j * 4), b4 = *(const LAS f32x4*)(biasl + g * 32 + j * 4);
#pragma unroll
                    for (int e = 0; e < 4; ++e) { const float v = s4[e] + b4[e]; const float t = fminf(m1, v); m1 = fmaxf(m1, v); m2 = fmaxf(m2, t); }
                }
                gscl[tk * 8 + g] = m1 + m2;
            }
        }
        __syncthreads();
        int gq = 0;
        {
            const f32x4 ga = *(const LAS f32x4*)(gscl + tk * 8), gb = *(const LAS f32x4*)(gscl + tk * 8 + 4);
            const float gsc[8] = {ga[0], ga[1], ga[2], ga[3], gb[0], gb[1], gb[2], gb[3]};
            int c = 0;
#pragma unroll
            for (int g = 0; g < 8; ++g) {
                int rank = 0;
#pragma unroll
                for (int g2 = 0; g2 < 8; ++g2) rank += ((gsc[g2] > gsc[g]) || (gsc[g2] == gsc[g] && g2 < g)) ? 1 : 0;
                const bool sel = rank < 4;
                gq = (sel && c == q) ? g : gq; c += sel ? 1 : 0;
            }
        }
        {
            float val[8], sv[8]; int idx[8];
#pragma unroll
            for (int k = 0; k < 8; ++k) { val[k] = -3e38f; sv[k] = 0.f; idx[k] = 0; }
#pragma unroll 1
            for (int j = 0; j < 8; ++j) {
                const f32x4 s4 = *(const LAS f32x4*)(scl + tk * SSTR + gq * 32 + j * 4), b4 = *(const LAS f32x4*)(biasl + gq * 32 + j * 4);
#pragma unroll
                for (int e = 0; e < 4; ++e) {
                    const float x = s4[e] + b4[e], sx = s4[e]; const int ix = gq * 32 + j * 4 + e;
                    bool c[8];
#pragma unroll
                    for (int k = 0; k < 8; ++k) c[k] = x > val[k];
#pragma unroll
                    for (int k = 7; k >= 1; --k) {
                        val[k] = c[k] ? (c[k - 1] ? val[k - 1] : x) : val[k];
                        sv[k] = c[k] ? (c[k - 1] ? sv[k - 1] : sx) : sv[k];
                        idx[k] = c[k] ? (c[k - 1] ? idx[k - 1] : ix) : idx[k];
                    }
                    val[0] = c[0] ? x : val[0]; sv[0] = c[0] ? sx : sv[0]; idx[0] = c[0] ? ix : idx[0];
                }
            }
            const int lb = (tk * 4 + q) * 8;
            *(LAS f32x4*)(lval + lb) = (f32x4){val[0], val[1], val[2], val[3]}; *(LAS f32x4*)(lval + lb + 4) = (f32x4){val[4], val[5], val[6], val[7]};
            *(LAS f32x4*)(lsv + lb) = (f32x4){sv[0], sv[1], sv[2], sv[3]}; *(LAS f32x4*)(lsv + lb + 4) = (f32x4){sv[4], sv[5], sv[6], sv[7]};
            *(LAS i32x4*)(lidx + lb) = (i32x4){idx[0], idx[1], idx[2], idx[3]}; *(LAS i32x4*)(lidx + lb + 4) = (i32x4){idx[4], idx[5], idx[6], idx[7]};
        }
        __syncthreads();
        if (act && q == 0) {
            int h0 = 0, h1 = 0, h2 = 0, h3 = 0; float ms[8]; int me[8]; float ssum = 0.f;
            const int lb = tk * 32;
#pragma unroll
            for (int k = 0; k < 8; ++k) {
                const float v0 = lval[lb + h0], v1 = lval[lb + 8 + h1], v2 = lval[lb + 16 + h2], v3 = lval[lb + 24 + h3];
                int best = 0; float bv = v0;
                if (v1 > bv) { bv = v1; best = 1; }
                if (v2 > bv) { bv = v2; best = 2; }
                if (v3 > bv) { bv = v3; best = 3; }
                const int hb = best == 0 ? h0 : best == 1 ? h1 : best == 2 ? h2 : h3;
                const int li = lb + best * 8 + hb;
                ms[k] = lsv[li]; me[k] = lidx[li]; ssum += ms[k];
                h0 += best == 0 ? 1 : 0; h1 += best == 1 ? 1 : 0; h2 += best == 2 ? 1 : 0; h3 += best == 3 ? 1 : 0;
            }
            const size_t t = (size_t)(base + tk);
            int pos[8]; float w[8];
#pragma unroll
            for (int k = 0; k < 8; ++k) { pos[k] = atomicAdd(&cnt[me[k] * CNT_STR], 1); w[k] = ms[k] / ssum * 2.5f; }
            *(i32x4*)(eidx + t * 8) = (i32x4){me[0], me[1], me[2], me[3]}; *(i32x4*)(eidx + t * 8 + 4) = (i32x4){me[4], me[5], me[6], me[7]};
            *(f32x4*)(gw + t * 8) = (f32x4){w[0], w[1], w[2], w[3]}; *(f32x4*)(gw + t * 8 + 4) = (f32x4){w[4], w[5], w[6], w[7]};
            *(i32x4*)(epos + t * 8) = (i32x4){pos[0], pos[1], pos[2], pos[3]}; *(i32x4*)(epos + t * 8 + 4) = (i32x4){pos[4], pos[5], pos[6], pos[7]};
        }
    }
}

DI void moe_prefix(const Params& p, int layer, ldsp lds) {
    LAS int* cntl = (LAS int*)(lds + LDS_MISC); LAS int* rs = cntl + 256; LAS int* ts = rs + 260;
    const int* cnt = (const int*)(p.ws + CTL_CNT) + layer * 256 * CNT_STR;
    const int tid = threadIdx.x;
    __syncthreads();
    if (tid < 256) cntl[tid] = cnt[tid * CNT_STR];
    __syncthreads();
    if (tid <= 256) {
        int a = 0, b = 0;
        for (int e = 0; e < tid; ++e) { const int c = cntl[e]; a += c; b += (c + 127) >> 7; }
        rs[tid] = a; ts[tid] = b;
    }
    __syncthreads();
}

DI void phase_fill(const Params& p, int layer, int ntok, ldsp lds) {
    moe_prefix(p, layer, lds);
    LAS int* rs = (LAS int*)(lds + LDS_MISC) + 256;
    const int* eidx = (const int*)(p.ws + WS_EIDX); const float* gw = (const float*)(p.ws + WS_GW); const int* epos = (const int*)(p.ws + WS_EPOS);
    int* rtok = (int*)(p.ws + WS_RTOK); float* rw = (float*)(p.ws + WS_RW);
    for (int i = blockIdx.x * NTHR + threadIdx.x; i < ntok * 8; i += gridDim.x * NTHR) {
        const int e = eidx[i]; const int dest = rs[e] + epos[i];
        rtok[dest] = i; rw[dest] = gw[i];
    }
}

struct ALoadGather {
    const u16* ubuf; const LAS int* tokrow;
    DI u32x4 operator()(int r, int k) const {
        int tr = tokrow[r]; tr = tr < 0 ? 0 : tr;
        return *(const u32x4*)(ubuf + (size_t)tr * D + k);
    }
};
struct BLoadGU {
    const float* W; int hf;
    DI f32x4 operator()(int k, int c) const {
        const int wc = c >> 6, w = c & 63;
        const int gcol = (w < 32) ? (hf * 128 + wc * 32 + w) : (256 + hf * 128 + wc * 32 + (w - 32));
        return *(const f32x4*)(W + (size_t)k * 512 + gcol);
    }
};

struct BLoad16GU {
    const u16* W; int hf;
    DI u32x4 operator()(int k, int c) const {
        const int wc = c >> 6, w = c & 63;
        const int gcol = (w < 32) ? (hf * 128 + wc * 32 + w) : (256 + hf * 128 + wc * 32 + (w - 32));
        return *(const u32x4*)(W + (size_t)k * 512 + gcol);
    }
};
DI void phase_experts(const Params& p, int layer, int ntok, bool lat_only, ldsp lds, u16* slotb, u16* shb) {
    moe_prefix(p, layer, lds);
    LAS int* cntl = (LAS int*)(lds + LDS_MISC); LAS int* rs = cntl + 256; LAS int* ts = rs + 260;
    LAS int* tokrow = ts + 260; LAS float* wrow = (LAS float*)(tokrow + 128); LAS int* orow = (LAS int*)(wrow + 128);
    const int tid = threadIdx.x, lane = tid & 63, wave = tid >> 6, wr = wave >> 2, wc = wave & 3, g = lane >> 4;
    const int* rtok = (const int*)(p.ws + WS_RTOK); const float* rw = (const float*)(p.ws + WS_RW);
    const u16* ubuf = (const u16*)(p.ws + WS_U);
    ldsp Hs = lds + LDS_HS;
    const int nrt = ts[256], nsh = ntok >> 7, total = nrt + nsh;
    const int vcu = (gridDim.x % 8 == 0) ? (int)((blockIdx.x % 8) * (gridDim.x / 8) + blockIdx.x / 8) : (int)blockIdx.x;
    for (int u = vcu; u < total; u += gridDim.x) {
        int e, r0, nrows;
        if (u < nrt) {
            int lo = 0, hi = 255;
            while (lo < hi) { const int mid = (lo + hi + 1) >> 1; if (ts[mid] <= u) lo = mid; else hi = mid - 1; }
            e = lo; const int j = u - ts[e]; r0 = rs[e] + j * 128; nrows = cntl[e] - j * 128; if (nrows > 128) nrows = 128;
        } else { e = 256; r0 = (u - nrt) * 128; nrows = 128; }
        __syncthreads();
        if (tid < 128) {
            if (e < 256) {
                if (tid < nrows) { const int fi = rtok[r0 + tid]; tokrow[tid] = tok_row(fi >> 3, lat_only); orow[tid] = fi; wrow[tid] = rw[r0 + tid]; }
                else { tokrow[tid] = -1; orow[tid] = 0; wrow[tid] = 0.f; }
            } else { tokrow[tid] = tok_row(r0 + tid, lat_only); orow[tid] = r0 + tid; wrow[tid] = 1.f; }
        }
        __syncthreads();
        const u16* W1 = (e < 256) ? (const u16*)(p.ws + WB_EIN) + ((size_t)layer * 256 + e) * 1024 * 512 : (const u16*)(p.ws + WB_SIN) + (size_t)layer * 1024 * 512;
        const u16* W2 = (e < 256) ? (const u16*)(p.ws + WB_EOUT) + ((size_t)layer * 256 + e) * 256 * 1024 : (const u16*)(p.ws + WB_SOUT) + (size_t)layer * 256 * 1024;
#pragma unroll 1
        for (int hf = 0; hf < 2; ++hf) {
            f32x4 acc[4][4];
#pragma unroll
            for (int i = 0; i < 4; ++i)
#pragma unroll
                for (int j = 0; j < 4; ++j) acc[i][j] = (f32x4){0.f, 0.f, 0.f, 0.f};
            ALoadGather al{ubuf, tokrow}; BLoad16GU bl{W1, hf};
            gemm_kloop16<true, A_STR>(lds, 16, al, bl, acc, (const LAS unsigned char*)nullptr);
#pragma unroll
            for (int mt = 0; mt < 4; ++mt)
#pragma unroll
                for (int nt = 0; nt < 2; ++nt)
#pragma unroll
                    for (int i = 0; i < 4; ++i) {
                        const int row = wr * 64 + mt * 16 + g * 4 + i, col = hf * 128 + wc * 32 + nt * 16 + (lane & 15);
                        const float hv = siluf_(acc[mt][nt][i]) * acc[mt][nt + 2][i];
                        *(LAS u16*)(Hs + row * B_STR + col * 2) = f2bf(hv);
                    }
        }
#pragma unroll 1
        for (int cq = 0; cq < 4; ++cq) {
            f32x4 acc[4][4];
#pragma unroll
            for (int i = 0; i < 4; ++i)
#pragma unroll
                for (int j = 0; j < 4; ++j) acc[i][j] = (f32x4){0.f, 0.f, 0.f, 0.f};
            ALoadNone al; BLoad16U bl{W2 + cq * 256, 1024};
            gemm_kloop16<false, B_STR>(lds, 4, al, bl, acc, Hs);
            ldsp wbuf = (wave < 4) ? (lds + LDS_AS + wave * 4608) : (lds + LDS_MISC + 8192 + (wave - 4) * 4608);
            u16* obase = ((e < 256) ? slotb : shb) + cq * 256 + wc * 64;
#pragma unroll
            for (int mp = 0; mp < 2; ++mp) {
#pragma unroll
                for (int m2 = 0; m2 < 2; ++m2)
#pragma unroll
                    for (int i = 0; i < 4; ++i) {
                        const int mt = mp * 2 + m2;
                        const float w = wrow[wr * 64 + mt * 16 + g * 4 + i];
#pragma unroll
                        for (int nt = 0; nt < 4; ++nt)
                            *(LAS u16*)(wbuf + (m2 * 16 + g * 4 + i) * 144 + (nt * 16 + (lane & 15)) * 2) = f2bf(acc[mt][nt][i] * w);
                    }
#pragma unroll
                for (int q = 0; q < 4; ++q) {
                    const int id = lane + 64 * q, rl = id >> 3, ch = id & 7;
                    const u32x4 v = *(const LAS u32x4*)(wbuf + rl * 144 + ch * 16);
                    const int row = wr * 64 + mp * 32 + rl;
                    if (tokrow[row] >= 0) *(u32x4*)(obase + (size_t)orow[row] * D + ch * 8) = v;
                }
            }
        }
    }
}


constexpr int LDS_X4 = LDS_BASE + 8 * 128 * 64 * 2;
DI void moe_prefix256(const Params& p, int layer, ldsp lds) {
    LAS int* cntl = (LAS int*)(lds + LDS_X4); LAS int* pt = cntl + 256; LAS int* wtot = pt + 260;
    const int* cnt = (const int*)(p.ws + CTL_CNT) + layer * 256 * CNT_STR;
    const int tid = threadIdx.x, lane = tid & 63, wave = tid >> 6;
    __syncthreads();
    int incl = 0;
    if (tid < 256) {
        const int c = cnt[tid * CNT_STR]; cntl[tid] = c; incl = (c + 255) >> 8;
#pragma unroll
        for (int o = 1; o <= 32; o <<= 1) { const int t = __shfl_up(incl, o); incl += (lane >= o) ? t : 0; }
        if (lane == 63) wtot[wave] = incl;
    }
    __syncthreads();
    if (tid < 256) {
        int off = 0;
#pragma unroll
        for (int w = 0; w < 3; ++w) off += (w < wave) ? wtot[w] : 0;
        pt[tid + 1] = off + incl;
        if (tid == 0) pt[0] = 0;
    }
    __syncthreads();
}
DI void phase_fill4(const Params& p, int layer, int ntok, bool lat_only, ldsp lds) {
    moe_prefix256(p, layer, lds);
    LAS int* cntl = (LAS int*)(lds + LDS_X4); LAS int* pt = cntl + 256;
    const int* eidx = (const int*)(p.ws + WS_EIDX); const float* gw = (const float*)(p.ws + WS_GW); const int* epos = (const int*)(p.ws + WS_EPOS);
    int* arow = (int*)(p.ws + WS_AROW); int* rtk = (int*)(p.ws + WS_RTK2); float* rw = (float*)(p.ws + WS_RW2);
    for (int i = blockIdx.x * NTHR + threadIdx.x; i < ntok * 8; i += gridDim.x * NTHR) {
        const int e = eidx[i]; const int dest = pt[e] * 256 + epos[i];
        arow[dest] = tok_row(i >> 3, lat_only); rtk[dest] = i; rw[dest] = gw[i];
    }
    for (int i = blockIdx.x * NTHR + threadIdx.x; i < 256 * 256; i += gridDim.x * NTHR) {
        const int e = i >> 8, j = i & 255; const int c = cntl[e]; const int pc = ((c + 255) >> 8) << 8;
        if (c + j < pc) { const int d = pt[e] * 256 + c + j; arow[d] = 0; rtk[d] = -1; rw[d] = 0.f; }
    }
}
DI void phase_experts4_g1(const Params& p, int layer, int ntok, bool lat_only, ldsp lds) {
    moe_prefix256(p, layer, lds);
    const LAS int* pt = (const LAS int*)(lds + LDS_X4) + 256;
    const int NT = pt[256], G = gridDim.x;
    const int vcu = (G % 8 == 0) ? (int)((blockIdx.x % 8) * (G / 8) + blockIdx.x / 8) : (int)blockIdx.x;
    pg8::ExpSched S{pt, NT, ntok >> 8, 2, G, vcu};
    pg8::AddrExp1 AD{(const u16*)(p.ws + WS_U), (const int*)(p.ws + WS_AROW), (const u16*)(p.ws + WT_IN) + (size_t)layer * 257 * 512 * 1024, NT, lat_only};
    pg8::gemm_phase_gather(lds + LDS_BASE, 1024, S, AD, pg8::EpiExpH{(u16*)(p.ws + WS_HG), NT});
}
DI void phase_experts4_g2(const Params& p, int layer, int ntok, ldsp lds, u16* slotb, u16* shb) {
    moe_prefix256(p, layer, lds);
    const LAS int* pt = (const LAS int*)(lds + LDS_X4) + 256;
    const int NT = pt[256], G = gridDim.x;
    const int vcu = (G % 8 == 0) ? (int)((blockIdx.x % 8) * (G / 8) + blockIdx.x / 8) : (int)blockIdx.x;
    pg8::ExpSched S{pt, NT, ntok >> 8, 4, G, vcu};
    pg8::AddrExp2 AD{(const u16*)(p.ws + WS_HG), (const u16*)(p.ws + WT_OUT) + (size_t)layer * 257 * 1024 * 256, NT};
    pg8::gemm_phase_st(lds + LDS_BASE, 256, S, AD, pg8::EpiExpOut{slotb, (long)(shb - slotb), (const int*)(p.ws + WS_RTK2), (const float*)(p.ws + WS_RW2), NT, (LAS u32x2*)(lds + LDS_X4 + 4096)});
}

DI void phase_mix(const Params& p) {
    const int lane = threadIdx.x & 63, wave = threadIdx.x >> 6;
    const float* zb = (const float*)(p.ws + WS_Z); u16* xm = (u16*)(p.ws + WS_XMIX); const float* mu = p.in[13];
    for (int row = blockIdx.x * 8 + wave; row < T; row += gridDim.x * 8) {
        const int n = row % NTOK;
        const bool hasp = !(n == 0 || n == CTXL), hasn = !(n == CTXL - 1 || n == NTOK - 1);
        const float fp = hasp ? 0.5f : 0.f, fn = hasn ? 0.5f : 0.f;
        const size_t rp = (size_t)(hasp ? row - 1 : row) * D, rn = (size_t)(hasn ? row + 1 : row) * D, rc = (size_t)row * D;
        f32x4 uc[4], up[4], un[4];
#pragma unroll
        for (int j = 0; j < 4; ++j) {
            const int col = lane * 4 + 256 * j;
            uc[j] = *(const f32x4*)(zb + rc + col); up[j] = *(const f32x4*)(zb + rp + col); un[j] = *(const f32x4*)(zb + rn + col);
        }
#pragma unroll
        for (int j = 0; j < 4; ++j) {
            const int col = lane * 4 + 256 * j;
            const f32x4 dx = fp * up[j] + fn * un[j] - uc[j];
#pragma unroll
            for (int m = 0; m < 6; ++m) {
                const f32x4 x = uc[j] + dx * *(const f32x4*)(mu + m * D + col);
                u32x2 o; o[0] = pack2(x[0], x[1]); o[1] = pack2(x[2], x[3]);
                *(u32x2*)(xm + ((size_t)m * T + row) * D + col) = o;
            }
        }
    }
}

constexpr int SM_STR = 144;
constexpr int SM_SZ = 64 * SM_STR;
DI s16x8 frag_row(const LAS unsigned char* P, int r0, int c0, int lane) {
    return *(const LAS s16x8*)(P + (r0 + (lane & 15)) * SM_STR + (c0 + 8 * (lane >> 4)) * 2);
}
DI s16x8 frag_tr(const LAS unsigned char* P, int r0, int c0, int lane) {
    const LAS unsigned char* a = P + (r0 + 8 * (lane >> 4) + ((lane >> 2) & 3)) * SM_STR + (c0 + 4 * (lane & 3)) * 2;
    const s16x4 lo = vtr(a), hi = vtr(a + 4 * SM_STR);
    return (s16x8){lo[0], lo[1], lo[2], lo[3], hi[0], hi[1], hi[2], hi[3]};
}
template <bool AT, bool BN>
DI void mm64(f32x4 (&acc)[2], const LAS unsigned char* X, const LAS unsigned char* Y, int mt, int nt0, int lane) {
#pragma unroll
    for (int ks = 0; ks < 2; ++ks) {
        const s16x8 a = AT ? frag_tr(X, ks * 32, mt * 16, lane) : frag_row(X, mt * 16, ks * 32, lane);
#pragma unroll
        for (int n = 0; n < 2; ++n) {
            const s16x8 b = BN ? frag_tr(Y, ks * 32, (nt0 + n) * 16, lane) : frag_row(Y, (nt0 + n) * 16, ks * 32, lane);
            acc[n] = __builtin_amdgcn_mfma_f32_16x16x32_bf16(a, b, acc[n], 0, 0, 0);
        }
    }
}
DI void st_tile(LAS unsigned char* P, const f32x4& v, int mt, int nt, int lane) {
#pragma unroll
    for (int i = 0; i < 4; ++i) *(LAS u16*)(P + (mt * 16 + 4 * (lane >> 4) + i) * SM_STR + (nt * 16 + (lane & 15)) * 2) = f2bf(v[i]);
}
#define ZERO2(a) do { a[0] = (f32x4){0.f, 0.f, 0.f, 0.f}; a[1] = (f32x4){0.f, 0.f, 0.f, 0.f}; } while (0)

DI void phase_scan(const Params& p, ldsp lds) {
    const int tid = threadIdx.x, lane = tid & 63, wave = tid >> 6, g = lane >> 4;
    const int mt = wave >> 1, nt0 = (wave & 1) * 2;
    const int tt = tid >> 3, c8 = tid & 7;
    ldsp base = lds + LDS_BASE;
#define SL(i) (base + (i) * SM_SZ)
    LAS float* CS = (LAS float*)SL(5);
    LAS float* gc = (LAS float*)(base + 16 * SM_SZ);
    const u16* rb = (const u16*)(p.ws + WS_R); const u16* kb = (const u16*)(p.ws + WS_K); const u16* vb = (const u16*)(p.ws + WS_V);
    for (int u = blockIdx.x; u < 256; u += gridDim.x) {
        const int b = u >> 5, h = (u >> 1) & 15, dir = u & 1;
        const u16* ab = (const u16*)(p.ws + WS_A0) + (size_t)dir * T * D;
        const float* lwb = (const float*)(p.ws + WS_W0) + (size_t)dir * T * D;
        float* yb = (float*)(p.ws + WS_Y) + (size_t)dir * TL * D;
        const int cofs = h * 64 + c8 * 8;
        const f32x4 kkw0 = *(const f32x4*)(p.in[24] + cofs), kkw1 = *(const f32x4*)(p.in[24] + cofs + 4);
        const f32x4 kaw0 = *(const f32x4*)(p.in[25] + cofs), kaw1 = *(const f32x4*)(p.in[25] + cofs + 4);
        __syncthreads();
        *(LAS u32x4*)(SL(14) + tt * SM_STR + c8 * 16) = (u32x4){0, 0, 0, 0};
        *(LAS u32x4*)(SL(15) + tt * SM_STR + c8 * 16) = (u32x4){0, 0, 0, 0};
        u32x4 pr, pk, pv, pa; f32x4 pw0, pw1;
#define SCAN_N(s) ((dir == 0) ? (s) : ((s) < CTXL ? (CTXL - 1 - (s)) : (NTOK + CTXL - 1 - (s))))
#define LOADC(c) { const size_t o_ = (size_t)(b * NTOK + SCAN_N((c) * 64 + tt)) * D + cofs; \
            pr = *(const u32x4*)(rb + o_); pk = *(const u32x4*)(kb + o_); pv = *(const u32x4*)(vb + o_); pa = *(const u32x4*)(ab + o_); \
            pw0 = *(const f32x4*)(lwb + o_); pw1 = *(const f32x4*)(lwb + o_ + 4); }
        LOADC(0);
        for (int c = 0; c < NTOK / 64; ++c) {
            const u32x4 cr = pr, ck = pk, cv = pv, ca = pa; const f32x4 cw0 = pw0, cw1 = pw1;
            __syncthreads();
            *(LAS f32x4*)(CS + tt * 64 + c8 * 8) = cw0; *(LAS f32x4*)(CS + tt * 64 + c8 * 8 + 4) = cw1;
            __syncthreads();
            {
                LAS float* TOT = gc + 64;
                const int col_ = tid & 63, seg_ = tid >> 6;
                float v_[8];
#pragma unroll
                for (int i = 0; i < 8; ++i) v_[i] = CS[(seg_ * 8 + i) * 64 + col_];
#pragma unroll
                for (int i = 1; i < 8; ++i) v_[i] += v_[i - 1];
                TOT[seg_ * 64 + col_] = v_[7];
                __syncthreads();
                float off_ = 0.f;
#pragma unroll
                for (int s2 = 0; s2 < 7; ++s2) { const float t_ = TOT[s2 * 64 + col_]; off_ += (s2 < seg_) ? t_ : 0.f; }
#pragma unroll
                for (int i = 0; i < 8; ++i) CS[(seg_ * 8 + i) * 64 + col_] = v_[i] + off_;
            }
            __syncthreads();
            {
                const f32x4 cc0 = *(const LAS f32x4*)(CS + tt * 64 + c8 * 8), cc1 = *(const LAS f32x4*)(CS + tt * 64 + c8 * 8 + 4);
                float cs[8], lwv[8], rr[8], kh[8], as[8];
#pragma unroll
                for (int j = 0; j < 4; ++j) { cs[j] = cc0[j]; cs[4 + j] = cc1[j]; lwv[j] = cw0[j]; lwv[4 + j] = cw1[j]; }
#pragma unroll
                for (int j = 0; j < 4; ++j) {
                    rr[2 * j] = bf2f((u16)(cr[j] & 0xffffu)); rr[2 * j + 1] = bf2f((u16)(cr[j] >> 16));
                    kh[2 * j] = bf2f((u16)(ck[j] & 0xffffu)); kh[2 * j + 1] = bf2f((u16)(ck[j] >> 16));
                    as[2 * j] = bf2f((u16)(ca[j] & 0xffffu)); as[2 * j + 1] = bf2f((u16)(ca[j] >> 16));
                }
                float kr[8]; float ss = 0.f;
#pragma unroll
                for (int j = 0; j < 8; ++j) { kr[j] = kh[j] * (j < 4 ? kkw0[j] : kkw1[j - 4]); ss += kr[j] * kr[j]; }
                ss += __shfl_xor(ss, 1); ss += __shfl_xor(ss, 2); ss += __shfl_xor(ss, 4);
                const float rn = rsqrtf(fmaxf(ss, 1e-24f));
                float at[8], bt[8], kt[8], rt[8];
#pragma unroll
                for (int j = 0; j < 8; ++j) {
                    const float kkv = kr[j] * rn;
                    const float e1 = __expf(cs[j] - lwv[j]), e2 = __expf(-cs[j]), e3 = __expf(cs[j]);
                    const float kaj = (j < 4 ? kaw0[j] : kaw1[j - 4]);
                    at[j] = -kkv * e1; bt[j] = kkv * as[j] * e2; kt[j] = kh[j] * (1.f + (as[j] - 1.f) * kaj) * e2; rt[j] = rr[j] * e3;
                    if (tt == 63) gc[c8 * 8 + j] = e3;
                }
                const int off = tt * SM_STR + c8 * 16;
                *(LAS u32x4*)(SL(0) + off) = (u32x4){pack2(at[0], at[1]), pack2(at[2], at[3]), pack2(at[4], at[5]), pack2(at[6], at[7])};
                *(LAS u32x4*)(SL(1) + off) = (u32x4){pack2(bt[0], bt[1]), pack2(bt[2], bt[3]), pack2(bt[4], bt[5]), pack2(bt[6], bt[7])};
                *(LAS u32x4*)(SL(2) + off) = (u32x4){pack2(kt[0], kt[1]), pack2(kt[2], kt[3]), pack2(kt[4], kt[5]), pack2(kt[6], kt[7])};
                *(LAS u32x4*)(SL(3) + off) = (u32x4){pack2(rt[0], rt[1]), pack2(rt[2], rt[3]), pack2(rt[4], rt[5]), pack2(rt[6], rt[7])};
                *(LAS u32x4*)(SL(4) + off) = cv;
            }
            { const int cn_ = (c + 1 < NTOK / 64) ? c + 1 : c; LOADC(cn_); }
            __syncthreads();
            f32x4 acc[2], Tacc[2], P2acc[2], AVacc[2];
            ZERO2(acc); mm64<false, false>(acc, SL(0), SL(1), mt, nt0, lane);
#pragma unroll
            for (int n = 0; n < 2; ++n) {
                const int nt = nt0 + n;
                const bool isD = (mt == nt), isO1 = ((mt >> 1) == (nt >> 1)) && (mt != nt), isO2 = ((mt >> 1) != (nt >> 1));
                f32x4 dv, o1v, o2v;
#pragma unroll
                for (int i = 0; i < 4; ++i) {
                    const int row = mt * 16 + 4 * g + i, col = nt * 16 + (lane & 15);
                    const float v = (col < row) ? acc[n][i] : 0.f;
                    dv[i] = isD ? v : 0.f; o1v[i] = isO1 ? v : 0.f; o2v[i] = isO2 ? v : 0.f;
                    Tacc[n][i] = dv[i] + (row == col ? 1.f : 0.f);
                }
                st_tile(SL(5), dv, mt, nt, lane); st_tile(SL(12), o1v, mt, nt, lane); st_tile(SL(13), o2v, mt, nt, lane);
                st_tile(SL(10), Tacc[n], mt, nt, lane);
            }
            ZERO2(acc); mm64<false, false>(acc, SL(0), SL(2), mt, nt0, lane);
#pragma unroll
            for (int n = 0; n < 2; ++n)
#pragma unroll
                for (int i = 0; i < 4; ++i) { const int row = mt * 16 + 4 * g + i, col = (nt0 + n) * 16 + (lane & 15); if (!(col < row)) acc[n][i] = 0.f; }
            st_tile(SL(7), acc[0], mt, nt0, lane); st_tile(SL(7), acc[1], mt, nt0 + 1, lane);
            ZERO2(acc); mm64<false, false>(acc, SL(3), SL(1), mt, nt0, lane);
#pragma unroll
            for (int n = 0; n < 2; ++n)
#pragma unroll
                for (int i = 0; i < 4; ++i) { const int row = mt * 16 + 4 * g + i, col = (nt0 + n) * 16 + (lane & 15); if (!(col <= row)) acc[n][i] = 0.f; }
            st_tile(SL(8), acc[0], mt, nt0, lane); st_tile(SL(8), acc[1], mt, nt0 + 1, lane);
            ZERO2(acc); mm64<false, false>(acc, SL(3), SL(2), mt, nt0, lane);
#pragma unroll
            for (int n = 0; n < 2; ++n)
#pragma unroll
                for (int i = 0; i < 4; ++i) { const int row = mt * 16 + 4 * g + i, col = (nt0 + n) * 16 + (lane & 15); if (!(col <= row)) acc[n][i] = 0.f; }
            st_tile(SL(9), acc[0], mt, nt0, lane); st_tile(SL(9), acc[1], mt, nt0 + 1, lane);
            ZERO2(P2acc); mm64<true, true>(P2acc, SL(2), SL(4), mt, nt0, lane);
            __syncthreads();
            ZERO2(acc); mm64<false, true>(acc, SL(5), SL(5), mt, nt0, lane);
            st_tile(SL(6), acc[0], mt, nt0, lane); st_tile(SL(6), acc[1], mt, nt0 + 1, lane);
            ZERO2(acc); mm64<false, true>(acc, SL(7), SL(4), mt, nt0, lane);
            st_tile(SL(11), acc[0], mt, nt0, lane); st_tile(SL(11), acc[1], mt, nt0 + 1, lane);
            ZERO2(AVacc); mm64<false, true>(AVacc, SL(9), SL(4), mt, nt0, lane);
            __syncthreads();
            mm64<false, true>(Tacc, SL(10), SL(6), mt, nt0, lane);
            st_tile(SL(2), Tacc[0], mt, nt0, lane); st_tile(SL(2), Tacc[1], mt, nt0 + 1, lane);
            ZERO2(acc); mm64<false, true>(acc, SL(6), SL(6), mt, nt0, lane);
            st_tile(SL(5), acc[0], mt, nt0, lane); st_tile(SL(5), acc[1], mt, nt0 + 1, lane);
            __syncthreads();
            mm64<false, true>(Tacc, SL(2), SL(5), mt, nt0, lane);
            st_tile(SL(10), Tacc[0], mt, nt0, lane); st_tile(SL(10), Tacc[1], mt, nt0 + 1, lane);
            __syncthreads();
            ZERO2(acc); mm64<false, true>(acc, SL(12), SL(10), mt, nt0, lane);
            st_tile(SL(5), acc[0], mt, nt0, lane); st_tile(SL(5), acc[1], mt, nt0 + 1, lane);
            __syncthreads();
            mm64<false, true>(Tacc, SL(10), SL(5), mt, nt0, lane);
            st_tile(SL(2), Tacc[0], mt, nt0, lane); st_tile(SL(2), Tacc[1], mt, nt0 + 1, lane);
            __syncthreads();
            ZERO2(acc); mm64<false, true>(acc, SL(13), SL(2), mt, nt0, lane);
            st_tile(SL(6), acc[0], mt, nt0, lane); st_tile(SL(6), acc[1], mt, nt0 + 1, lane);
            __syncthreads();
            mm64<false, true>(Tacc, SL(2), SL(6), mt, nt0, lane);
            st_tile(SL(10), Tacc[0], mt, nt0, lane); st_tile(SL(10), Tacc[1], mt, nt0 + 1, lane);
            __syncthreads();
            ZERO2(acc); mm64<false, true>(acc, SL(10), SL(0), mt, nt0, lane);
            st_tile(SL(7), acc[0], mt, nt0, lane); st_tile(SL(7), acc[1], mt, nt0 + 1, lane);
            ZERO2(acc); mm64<false, true>(acc, SL(10), SL(11), mt, nt0, lane);
            st_tile(SL(9), acc[0], mt, nt0, lane); st_tile(SL(9), acc[1], mt, nt0 + 1, lane);
            __syncthreads();
            ZERO2(acc); mm64<true, true>(acc, SL(1), SL(7), mt, nt0, lane);
#pragma unroll
            for (int n = 0; n < 2; ++n)
#pragma unroll
                for (int i = 0; i < 4; ++i) { const int row = mt * 16 + 4 * g + i, col = (nt0 + n) * 16 + (lane & 15); acc[n][i] = gc[row] * (acc[n][i] + (row == col ? 1.f : 0.f)); }
            st_tile(SL(12), acc[0], mt, nt0, lane); st_tile(SL(12), acc[1], mt, nt0 + 1, lane);
            mm64<true, true>(P2acc, SL(1), SL(9), mt, nt0, lane);
#pragma unroll
            for (int n = 0; n < 2; ++n)
#pragma unroll
                for (int i = 0; i < 4; ++i) P2acc[n][i] *= gc[mt * 16 + 4 * g + i];
#pragma unroll
            for (int n = 0; n < 2; ++n)
#pragma unroll
                for (int i = 0; i < 4; ++i) acc[n][i] = bf2f(*(const LAS u16*)(SL(3) + (mt * 16 + 4 * g + i) * SM_STR + ((nt0 + n) * 16 + (lane & 15)) * 2));
            mm64<false, true>(acc, SL(8), SL(7), mt, nt0, lane);
            st_tile(SL(13), acc[0], mt, nt0, lane); st_tile(SL(13), acc[1], mt, nt0 + 1, lane);
            mm64<false, true>(AVacc, SL(8), SL(9), mt, nt0, lane);
            __syncthreads();
            mm64<false, true>(AVacc, SL(13), SL(14), mt, nt0, lane); mm64<false, true>(AVacc, SL(13), SL(15), mt, nt0, lane);
            mm64<false, true>(P2acc, SL(12), SL(14), mt, nt0, lane); mm64<false, true>(P2acc, SL(12), SL(15), mt, nt0, lane);
            if (c >= CTXL / 64) {
#pragma unroll
                for (int n = 0; n < 2; ++n)
#pragma unroll
                    for (int i = 0; i < 4; ++i) {
                        const int tq = mt * 16 + 4 * g + i;
                        const int nn = SCAN_N(c * 64 + tq);
                        yb[(size_t)(b * SEQ + nn - CTXL) * D + h * 64 + (nt0 + n) * 16 + (lane & 15)] = AVacc[n][i];
                    }
            }
            __syncthreads();
#pragma unroll
            for (int n = 0; n < 2; ++n)
#pragma unroll
                for (int i = 0; i < 4; ++i) {
                    const float hv = P2acc[n][i];
                    const u16 hi = f2bf(hv); const u16 lo = f2bf(hv - bf2f(hi));
                    const int off = (mt * 16 + 4 * g + i) * SM_STR + ((nt0 + n) * 16 + (lane & 15)) * 2;
                    *(LAS u16*)(SL(14) + off) = hi; *(LAS u16*)(SL(15) + off) = lo;
                }
        }
#undef LOADC
#undef SCAN_N
    }
#undef SL
}

DI void phase_post(const Params& p) {
    const int lane = threadIdx.x & 63, wave = threadIdx.x >> 6;
    const float* y0b = (const float*)(p.ws + WS_Y); const float* y1b = y0b + (size_t)TL * D;
    const u16* rb = (const u16*)(p.ws + WS_R); const u16* kb = (const u16*)(p.ws + WS_K); const u16* vb = (const u16*)(p.ws + WS_V);
    const u16* a0b = (const u16*)(p.ws + WS_A0); const u16* a1b = a0b + (size_t)T * D;
    const u16* gb = (const u16*)(p.ws + WS_G); u16* ao = (u16*)(p.ws + WS_AO);
    const float* lnx0 = p.in[27]; const float* lnx1 = p.in[27] + D; const float* kaw = p.in[25]; const float* rkw = p.in[26];
    for (int m = blockIdx.x * 8 + wave; m < TL; m += gridDim.x * 8) {
        const int row = (m >> 11) * NTOK + CTXL + (m & 2047);
        f32x4 y0v[4], y1v[4]; u32x2 rr[4], kk[4], vv_[4], a0v[4], a1v[4], gg[4];
#pragma unroll
        for (int j = 0; j < 4; ++j) {
            const int col = lane * 4 + 256 * j; const size_t o = (size_t)row * D + col;
            y0v[j] = __builtin_nontemporal_load((const f32x4*)(y0b + (size_t)m * D + col)); y1v[j] = __builtin_nontemporal_load((const f32x4*)(y1b + (size_t)m * D + col));
            rr[j] = __builtin_nontemporal_load((const u32x2*)(rb + o)); kk[j] = __builtin_nontemporal_load((const u32x2*)(kb + o)); vv_[j] = __builtin_nontemporal_load((const u32x2*)(vb + o));
            a0v[j] = __builtin_nontemporal_load((const u32x2*)(a0b + o)); a1v[j] = __builtin_nontemporal_load((const u32x2*)(a1b + o)); gg[j] = __builtin_nontemporal_load((const u32x2*)(gb + o));
        }
#define BF4(v_) ((f32x4){__uint_as_float((v_)[0] << 16), __uint_as_float((v_)[0] & 0xffff0000u), __uint_as_float((v_)[1] << 16), __uint_as_float((v_)[1] & 0xffff0000u)})
#pragma unroll
        for (int j = 0; j < 4; ++j) {
            const int col = lane * 4 + 256 * j;
            const f32x4 y = y0v[j] + y1v[j];
            const float ym = wsum16(y[0] + y[1] + y[2] + y[3]) * (1.f / 64.f);
            const f32x4 d = y - ym;
            const float yv = wsum16(d[0] * d[0] + d[1] * d[1] + d[2] * d[2] + d[3] * d[3]) * (1.f / 64.f);
            const f32x4 yn = d * rsqrtf(yv + 64e-5f) * *(const f32x4*)(lnx0 + col) + *(const f32x4*)(lnx1 + col);
            const size_t o = (size_t)row * D + col;
            const f32x4 r = BF4(rr[j]), k = BF4(kk[j]), vv = BF4(vv_[j]);
            const f32x4 a0 = BF4(a0v[j]), a1 = BF4(a1v[j]);
            const f32x4 ks = k * (2.f + (a0 + a1 - 2.f) * *(const f32x4*)(kaw + col));
            const f32x4 t = r * ks * *(const f32x4*)(rkw + col);
            const float bs = wsum16(t[0] + t[1] + t[2] + t[3]);
            const f32x4 outv = (yn + bs * vv) * BF4(gg[j]);
            u32x2 ov; ov[0] = pack2(outv[0], outv[1]); ov[1] = pack2(outv[2], outv[3]);
            *(u32x2*)(ao + o) = ov;
        }
#undef BF4
    }
}

constexpr int NPH = 25;
__global__ void __launch_bounds__(NTHR, 2) mk_fwd(Params p) {
    extern __shared__ __attribute__((aligned(16))) unsigned char lds_raw[];
    ldsp lds = (ldsp)lds_raw;
    if (threadIdx.x < 4) ((LAS unsigned*)lds)[threadIdx.x] = 0u;
    __syncthreads();
    const bool multi = (p.ph_hi - p.ph_lo) > 1;
    XcdBarrier bar; bar.bar = (unsigned*)(p.ws + WS_CTL); bar.x = 0; bar.st = (volatile LAS unsigned*)lds;
    if (multi) bar = xcd_barrier_post((unsigned*)(p.ws + WS_CTL), (volatile LAS unsigned*)lds);
    const int lo = p.ph_lo, hi = p.ph_hi;
#define IN(k) (lo <= (k) && (k) < hi)
#define SEAM(k) do { if (IN(k) && IN((k) + 1)) xcd_barrier(bar); } while (0)
    u16* ubuf = (u16*)(p.ws + WS_U); u16* hp = (u16*)(p.ws + WS_HP); u16* ao = (u16*)(p.ws + WS_AO);
    float* zbuf = (float*)(p.ws + WS_Z); float* hbuf = (float*)(p.ws + WS_H);
    const float* modbase = (const float*)(p.ws + WS_MODS);

    if (IN(0)) { phase_ada(p, lds); phase_cvt(p, lds); } SEAM(0);
    if (IN(1)) { phase_mod0(p); } SEAM(1);
#ifdef PROBE_INPROJ2
    if (IN(2)) {
        LAS f32x2* tab = (LAS f32x2*)(lds + LDS_MISC);
        gemm_phase(lds, ubuf, D, T, BtDesc{(const u16*)(p.ws + WB_WIN), D, D, HPW}, RowAll{}, EpiInProj{hp, tab});
        xcd_barrier(bar);
    }
#endif
    if (IN(2)) {
        LAS f32x2* tab = (LAS f32x2*)(lds + LDS_PG8_TAB);
        __syncthreads();
        for (int i = threadIdx.x; i < 1024; i += NTHR) {
            const int pos = i >> 4, f = i & 15;
            const float inv = exp2f(-(float)f * (13.287712379549449f / 16.f));
            const float ang = (float)pos * inv;
            tab[i] = (f32x2){cosf(ang), sinf(ang)};
        }
        __syncthreads();
        pg8::Order S; S.init(T, HPW, 1, gridDim.x, blockIdx.x);
        pg8::gemm_phase(lds + LDS_BASE, D, S, pg8::AddrOne{ubuf, (const u16*)(p.ws + WB_WIN), D, false}, pg8::EpiInProjP{hp, tab});
    } SEAM(2);
#ifdef PROBE_ATTN2
    if (IN(3)) { phase_attn(p, lds); xcd_barrier(bar); }
#endif
    if (IN(3)) { phase_attn(p, lds); } SEAM(3);
    if (IN(4)) { pg8::Order S; S.init(T, D, 1, gridDim.x, blockIdx.x); __syncthreads();
        pg8::gemm_phase(lds + LDS_BASE, D, S, pg8::AddrOne{ao, (const u16*)(p.ws + WB_WOUT), D, false}, pg8::EpiResidP{zbuf, hbuf, modbase, 0, false}); } SEAM(4);
    if (IN(5)) { phase_ln<0>(p, 0, false); } SEAM(5);
    if (IN(6)) { gemm_phase_f32(lds, ubuf, D, T, 256, D, RowAll{}, MakeBDenseF{p.in[28], 256, D, 256}, EpiSigScore{(float*)(p.ws + WS_SC)});
                 bg_idle_run(p, T / 128, bg_s1(), bg_s2()); } SEAM(6);
    if (IN(7)) { phase_topk(p, 0, T, lds); } SEAM(7);
    if (IN(8)) { phase_fill4(p, 0, T, false, lds); } SEAM(8);
    if (IN(9)) { phase_experts4_g1(p, 0, T, false, lds); } SEAM(9);
    if (IN(10)) { phase_experts4_g2(p, 0, T, lds, (u16*)(p.ws + WS_SLOT), (u16*)(p.ws + WS_SH)); } SEAM(10);
    if (IN(11)) { phase_ln<1>(p, 0, false); } SEAM(11);
    if (IN(12)) { phase_mix(p); } SEAM(12);
#ifdef PROBE_R2
    for (int rep = 0; rep < 2; ++rep)
#endif
    if (IN(13)) {
        pg8::OrderRkvLora S; S.init(gridDim.x, blockIdx.x); __syncthreads();
        pg8::gemm_phase_s(lds + LDS_BASE, D, S, pg8::AddrRkvLora{p.ws}, pg8::EpiRkvLora{p.ws});
    } SEAM(13);
#ifdef PROBE_R3
    for (int rep = 0; rep < 2; ++rep)
#endif
    if (IN(14)) {
        const int G_ = (int)gridDim.x, q_ = (int)blockIdx.x % 5, mem_ = (int)blockIdx.x / 5, str_ = (G_ - q_ + 4) / 5;
        if (G_ >= 5) {
            if (q_ < 4) {
                const int d = q_ & 1;
                if (q_ < 2) gemm_phase(lds, (const u16*)(p.ws + WS_LW) + 64 * d, 128, T, BtDesc{(const u16*)(p.ws + WB_DEC2) + (size_t)d * 64 * D, 64, 64, D}, RowAll{},
                                       EpiDecay{(float*)(p.ws + WS_W0) + (size_t)d * T * D, p.in[16] + d * D}, mem_, str_);
                else        gemm_phase(lds, (const u16*)(p.ws + WS_LA) + 64 * d, 128, T, BtDesc{(const u16*)(p.ws + WB_ICL2) + (size_t)d * 64 * D, 64, 64, D}, RowAll{},
                                       EpiSigBias{(u16*)(p.ws + WS_A0) + (size_t)d * T * D, p.in[19] + d * D}, mem_, str_);
            } else {
                gemm_phase(lds, (const u16*)(p.ws + WS_SG), 192, T, BtDesc{(const u16*)(p.ws + WB_G2), 192, 160, D}, RowAll{}, EpiBf16<0>{(u16*)(p.ws + WS_G), D, D}, mem_, str_);
            }
        } else {
            for (int d = 0; d < 2; ++d) {
                gemm_phase(lds, (const u16*)(p.ws + WS_LW) + 64 * d, 128, T, BtDesc{(const u16*)(p.ws + WB_DEC2) + (size_t)d * 64 * D, 64, 64, D}, RowAll{},
                           EpiDecay{(float*)(p.ws + WS_W0) + (size_t)d * T * D, p.in[16] + d * D});
                gemm_phase(lds, (const u16*)(p.ws + WS_LA) + 64 * d, 128, T, BtDesc{(const u16*)(p.ws + WB_ICL2) + (size_t)d * 64 * D, 64, 64, D}, RowAll{},
                           EpiSigBias{(u16*)(p.ws + WS_A0) + (size_t)d * T * D, p.in[19] + d * D});
            }
            gemm_phase(lds, (const u16*)(p.ws + WS_SG), 192, T, BtDesc{(const u16*)(p.ws + WB_G2), 192, 160, D}, RowAll{}, EpiBf16<0>{(u16*)(p.ws + WS_G), D, D});
        }
    } SEAM(14);
    if (IN(15)) { phase_scan(p, lds); } SEAM(15);
    if (IN(16)) { phase_post(p); } SEAM(16);
    if (IN(17)) { pg8::Order S; S.init(TL, D, 1, gridDim.x, blockIdx.x); __syncthreads();
        pg8::gemm_phase(lds + LDS_BASE, D, S, pg8::AddrOne{ao, (const u16*)(p.ws + WB_RKO), D, true}, pg8::EpiResidP{zbuf, hbuf, modbase, 1, true}); } SEAM(17);
    if (IN(18)) { phase_ln<0>(p, 1, true); } SEAM(18);
    if (IN(19)) { gemm_phase_f32(lds, ubuf, D, TL, 256, D, RowLat{}, MakeBDenseF{p.in[28] + (size_t)D * 256, 256, D, 256}, EpiSigScore{(float*)(p.ws + WS_SC)});
                  bg_idle_run(p, TL / 128, bg_s2(), BG_NSTRIP); } SEAM(19);
    if (IN(20)) { phase_topk(p, 1, TL, lds); } SEAM(20);
    if (IN(21)) { phase_fill4(p, 1, TL, true, lds); } SEAM(21);
    if (IN(22)) { phase_experts4_g1(p, 1, TL, true, lds); } SEAM(22);
    if (IN(23)) { phase_experts4_g2(p, 1, TL, lds, (u16*)(p.ws + WS_SLOT), (u16*)(p.ws + WS_SH)); } SEAM(23);
    if (IN(24)) { phase_ln<2>(p, 1, true); }
#undef IN
#undef SEAM
}

extern "C" void kernel_launch(void* const* d_in, const int* in_sizes, int n_in, void* d_out, int out_size, void* d_ws, size_t ws_size, hipStream_t stream) {
    static int grid = 0;
    if (grid == 0) {
        if (n_in != 34 || ws_size < WS_END) { fprintf(stderr, "kernel_launch: unexpected n_in %d / ws %zu (need %zu)\n", n_in, ws_size, (size_t)WS_END); grid = -1; return; }
        int dev = 0, cus = 0;
        if (hipGetDevice(&dev) != hipSuccess || hipDeviceGetAttribute(&cus, hipDeviceAttributeMultiprocessorCount, dev) != hipSuccess) { grid = -1; return; }
        if (hipFuncSetAttribute((const void*)mk_fwd, hipFuncAttributeMaxDynamicSharedMemorySize, LDS_BYTES) != hipSuccess) { fprintf(stderr, "kernel_launch: hipFuncSetAttribute failed\n"); grid = -1; return; }
        int per_cu = 0;
        if (hipOccupancyMaxActiveBlocksPerMultiprocessor(&per_cu, (const void*)mk_fwd, NTHR, LDS_BYTES) != hipSuccess || per_cu < 1) fprintf(stderr, "kernel_launch: occupancy query says %d\n", per_cu);
        (void)hipGetLastError();
        grid = cus;
    }
    if (grid < 0) return;
    (void)hipMemsetAsync((char*)d_ws + WS_CTL, 0, CTL_BYTES, stream);
    Params p{};
    for (int i = 0; i < 34; ++i) p.in[i] = (const float*)d_in[i];
    p.out = (float*)d_out; p.ws = (unsigned char*)d_ws;
#if MK_ONE_LAUNCH
    p.ph_lo = 0; p.ph_hi = NPH;
    hipLaunchKernelGGL(mk_fwd, dim3(grid), dim3(NTHR), LDS_BYTES, stream, p);
#else
    for (int ph = 0; ph < NPH; ++ph) { p.ph_lo = ph; p.ph_hi = ph + 1; hipLaunchKernelGGL(mk_fwd, dim3(grid), dim3(NTHR), LDS_BYTES, stream, p); }
#endif
}
```
